# Optimizing an MI355X kernel written in HIP

```python
import jax, jax.numpy as jnp
from jax import lax
import numpy as np

D_MODEL = 1024
BATCH = 32
SEQ = 2048
DEPTH = 4

POOL_WINDOWS = (2, 4, 8, 16)
N_POOL_GROUPS = len(POOL_WINDOWS)
POOL_WIDTH = D_MODEL // 2
POOL_GROUP_DIM = POOL_WIDTH // N_POOL_GROUPS
ATT_HEADS = 8
ATT_KV_HEADS = 2
ATT_GROUP = ATT_HEADS // ATT_KV_HEADS
ATT_HEAD_DIM = 64
ATT_WIDTH = ATT_HEADS * ATT_HEAD_DIM
ATT_KV_WIDTH = ATT_KV_HEADS * ATT_HEAD_DIM
WINDOW = 128
BLOCK = 128
EVEN_IN = 2 * POOL_WIDTH + 2 * ATT_WIDTH + 2 * ATT_KV_WIDTH
MIX_WIDTH_EVEN = POOL_WIDTH + ATT_WIDTH

GLA_HEADS = 4
GLA_KEY_WIDTH = D_MODEL // 2
GLA_VAL_WIDTH = D_MODEL
GLA_DK = GLA_KEY_WIDTH // GLA_HEADS
GLA_DV = GLA_VAL_WIDTH // GLA_HEADS
GLA_GATE_RANK = 16
GLA_GATE_NORMALIZER = 16.0
GLA_CHUNK = 64
ODD_IN = 2 * GLA_KEY_WIDTH + 2 * GLA_VAL_WIDTH + 2 * GLA_GATE_RANK

N_EVEN = (DEPTH + 1) // 2
N_ODD = DEPTH // 2
EPS = 1e-6
NEG = -1e30

kernel_name = 'bidir_pool_swa_gla_hybrid'


def rms_norm(x, w):
    xf = x.astype(jnp.float32)
    y = xf * lax.rsqrt(jnp.mean(xf * xf, axis=-1, keepdims=True) + EPS)
    return (y * w.astype(jnp.float32)).astype(x.dtype)


def split_cols(a, sizes):
    return jnp.split(a, np.cumsum(sizes)[:-1].tolist(), axis=-1)


def pool_mixer(u, w_pool, scale):
    B, S, _ = u.shape
    uf = u.astype(jnp.float32).reshape(B, S, N_POOL_GROUPS, POOL_GROUP_DIM)
    cs = jnp.concatenate([jnp.zeros((B, 1, N_POOL_GROUPS, POOL_GROUP_DIM), jnp.float32),
                          jnp.cumsum(uf, axis=1)], axis=1)
    t = jnp.arange(S)
    means = []
    for g, w in enumerate(POOL_WINDOWS):
        lo = jnp.clip(t - w // 2, 0, S - 1)
        hi = jnp.clip(t + w // 2 - 1, 0, S - 1)
        cs_g = cs[:, :, g]
        tot = jnp.take(cs_g, hi + 1, axis=1) - jnp.take(cs_g, lo, axis=1)
        cnt = (hi - lo + 1).astype(jnp.float32)[None, :, None]
        means.append(tot / cnt)
    pooled = jnp.stack(means, axis=2) - uf
    y = jnp.einsum('bsgc,gcd->bsgd', pooled, w_pool.astype(jnp.float32))
    y = y.reshape(B, S, POOL_WIDTH) * scale.astype(jnp.float32)
    return y.astype(u.dtype)


def windowed_gqa(q, k, v, sink):
    B, S, _, _ = q.shape
    nb = S // BLOCK
    scale = ATT_HEAD_DIM ** -0.5
    slopes = (2.0 ** (-8.0 * jnp.arange(1, ATT_HEADS + 1, dtype=jnp.float32) / ATT_HEADS))
    slopes = slopes.reshape(ATT_KV_HEADS, ATT_GROUP)[None, :, :, None, None]
    sink_b = sink.astype(jnp.float32).reshape(ATT_KV_HEADS, ATT_GROUP)[None, :, :, None, None]
    pad = ((0, 0), (BLOCK, BLOCK), (0, 0), (0, 0))
    kp = jnp.pad(k, pad)
    vp = jnp.pad(v, pad)

    def block(i):
        qi = lax.dynamic_slice_in_dim(q, i * BLOCK, BLOCK, axis=1)
        qi = qi.reshape(B, BLOCK, ATT_KV_HEADS, ATT_GROUP, ATT_HEAD_DIM)
        ki = lax.dynamic_slice_in_dim(kp, i * BLOCK, 3 * BLOCK, axis=1)
        vi = lax.dynamic_slice_in_dim(vp, i * BLOCK, 3 * BLOCK, axis=1)
        s = jnp.einsum('bqkgd,bjkd->bkgqj', qi, ki) * scale
        tq = i * BLOCK + jnp.arange(BLOCK)
        sk = i * BLOCK - BLOCK + jnp.arange(3 * BLOCK)
        dist = jnp.abs(tq[:, None] - sk[None, :])
        valid = (dist <= WINDOW) & (sk >= 0)[None, :] & (sk < S)[None, :]
        s = s - slopes * dist.astype(jnp.float32)
        s = jnp.where(valid, s, NEG)
        m = jnp.maximum(jnp.max(s, axis=-1, keepdims=True), sink_b)
        p = jnp.exp(s - m)
        denom = jnp.sum(p, axis=-1) + jnp.exp(sink_b - m)[..., 0]
        o = jnp.einsum('bkgqj,bjkd->bqkgd', p, vi)
        o = o / jnp.transpose(denom, (0, 3, 1, 2))[..., None]
        return o.reshape(B, BLOCK, ATT_HEADS, ATT_HEAD_DIM)

    out = lax.map(block, jnp.arange(nb))
    return jnp.moveaxis(out, 0, 1).reshape(B, S, ATT_WIDTH)


def gla_direction(q, k, v, g, strict):
    B, S, H, DK = q.shape
    DV = v.shape[-1]
    C = GLA_CHUNK
    nc = S // C
    q = q.reshape(B, nc, C, H, DK)
    k = k.reshape(B, nc, C, H, DK)
    v = v.reshape(B, nc, C, H, DV)
    b = jnp.cumsum(g.reshape(B, nc, C, H, DK), axis=2)
    ref = b[:, :, C // 2:C // 2 + 1]
    b_last = b[:, :, -1]
    att = jnp.einsum('bnihk,bnjhk->bnhij', q * jnp.exp(b - ref), k * jnp.exp(ref - b))
    mask = jnp.tril(jnp.ones((C, C), dtype=bool), k=-1 if strict else 0)
    att = jnp.where(mask, att, 0.0)
    o_intra = jnp.einsum('bnhij,bnjhv->bnihv', att, v)
    q_x = q * jnp.exp(b)
    k_x = k * jnp.exp(b_last[:, :, None] - b)
    decay = jnp.exp(b_last)

    def step(state, xs):
        qc, kc, vc, dc = xs
        o = jnp.einsum('bihk,bhkv->bihv', qc, state)
        state = dc[..., None] * state + jnp.einsum('bjhk,bjhv->bhkv', kc, vc)
        return state, o

    xs = (jnp.moveaxis(q_x, 1, 0), jnp.moveaxis(k_x, 1, 0), jnp.moveaxis(v, 1, 0), jnp.moveaxis(decay, 1, 0))
    _, o_inter = lax.scan(step, jnp.zeros((B, H, DK, DV), jnp.float32), xs)
    o = o_intra + jnp.moveaxis(o_inter, 0, 1)
    return o.reshape(B, S, H, DV)


def even_mixer(h, w_in, w_pool, pool_scale, q_norm_w, k_norm_w, sink, w_out):
    B, S, _ = h.shape
    proj = h @ w_in
    u_pool, z_pool, q, k, v, z_att = split_cols(
        proj, [POOL_WIDTH, POOL_WIDTH, ATT_WIDTH, ATT_KV_WIDTH, ATT_KV_WIDTH, ATT_WIDTH])
    y_pool = pool_mixer(u_pool, w_pool, pool_scale) * jax.nn.silu(z_pool)
    q = rms_norm(q.reshape(B, S, ATT_HEADS, ATT_HEAD_DIM).astype(jnp.float32), q_norm_w)
    k = rms_norm(k.reshape(B, S, ATT_KV_HEADS, ATT_HEAD_DIM).astype(jnp.float32), k_norm_w)
    v = v.reshape(B, S, ATT_KV_HEADS, ATT_HEAD_DIM).astype(jnp.float32)
    y_att = windowed_gqa(q, k, v, sink).astype(h.dtype) * jax.nn.silu(z_att)
    return jnp.concatenate([y_pool, y_att], axis=-1) @ w_out


def odd_mixer(h, w_in, w_gate_up, b_gate, gla_norm_w, w_out):
    B, S, _ = h.shape
    proj = h @ w_in
    q, k, v, z, a_f, a_b = split_cols(
        proj, [GLA_KEY_WIDTH, GLA_KEY_WIDTH, GLA_VAL_WIDTH, GLA_VAL_WIDTH, GLA_GATE_RANK, GLA_GATE_RANK])
    q = q.reshape(B, S, GLA_HEADS, GLA_DK).astype(jnp.float32) * (GLA_DK ** -0.5)
    k = k.reshape(B, S, GLA_HEADS, GLA_DK).astype(jnp.float32)
    v = v.reshape(B, S, GLA_HEADS, GLA_DV).astype(jnp.float32)

    def log_gate(a, d):
        logits = (a @ w_gate_up[d] + b_gate[d]).astype(jnp.float32)
        return (jax.nn.log_sigmoid(logits) / GLA_GATE_NORMALIZER).reshape(B, S, GLA_HEADS, GLA_DK)

    g_f = log_gate(a_f, 0)
    g_b = log_gate(a_b, 1)
    o_f = gla_direction(q, k, v, g_f, False)
    o_b = jnp.flip(gla_direction(jnp.flip(q, 1), jnp.flip(k, 1), jnp.flip(v, 1), jnp.flip(g_b, 1), True), 1)
    o = rms_norm(o_f + o_b, gla_norm_w).reshape(B, S, GLA_VAL_WIDTH)
    return (o.astype(h.dtype) * jax.nn.silu(z)) @ w_out


def setup_inputs(seed: int = 0) -> dict:
    key = jax.random.key(seed)
    ks = jax.random.split(key, 20)
    f32 = jnp.float32
    nrm = lambda k_, shape, s: jax.random.normal(k_, shape, f32) * s
    D = D_MODEL
    return {
        'x': nrm(ks[0], (BATCH, SEQ, D), 1.0),
        'c': nrm(ks[1], (BATCH, D), 1.0),
        'norm_w': 1.0 + nrm(ks[2], (DEPTH, D), 0.02),
        'w_ada': nrm(ks[3], (DEPTH, D, 3 * D), 0.2 * D ** -0.5),
        'b_ada': nrm(ks[4], (DEPTH, 3 * D), 0.02),
        'w_in_a': nrm(ks[5], (N_EVEN, D, EVEN_IN), D ** -0.5),
        'w_pool': nrm(ks[6], (N_EVEN, N_POOL_GROUPS, POOL_GROUP_DIM, POOL_GROUP_DIM), POOL_GROUP_DIM ** -0.5),
        'pool_scale': 1.0 + nrm(ks[7], (N_EVEN, POOL_WIDTH), 0.02),
        'q_norm_w': 1.0 + nrm(ks[8], (N_EVEN, ATT_HEAD_DIM), 0.02),
        'k_norm_w': 1.0 + nrm(ks[9], (N_EVEN, ATT_HEAD_DIM), 0.02),
        'attn_sink': nrm(ks[10], (N_EVEN, ATT_HEADS), 0.5),
        'w_out_a': nrm(ks[11], (N_EVEN, MIX_WIDTH_EVEN, D), MIX_WIDTH_EVEN ** -0.5),
        'w_in_c': nrm(ks[12], (N_ODD, D, ODD_IN), D ** -0.5),
        'w_gate_up': nrm(ks[13], (N_ODD, 2, GLA_GATE_RANK, GLA_KEY_WIDTH), GLA_GATE_RANK ** -0.5),
        'b_gate': nrm(ks[14], (N_ODD, 2, GLA_KEY_WIDTH), 0.01),
        'gla_norm_w': 1.0 + nrm(ks[15], (N_ODD, GLA_DV), 0.02),
        'w_out_c': nrm(ks[16], (N_ODD, GLA_VAL_WIDTH, D), GLA_VAL_WIDTH ** -0.5),
    }


def reference(x, c, norm_w, w_ada, b_ada, w_in_a, w_pool, pool_scale, q_norm_w, k_norm_w,
              attn_sink, w_out_a, w_in_c, w_gate_up, b_gate, gla_norm_w, w_out_c):
    for l in range(DEPTH):
        mod = jax.nn.silu(c) @ w_ada[l] + b_ada[l]
        shift, scale, gate = jnp.split(mod, 3, axis=-1)
        h = rms_norm(x, norm_w[l]) * (1.0 + scale[:, None, :]) + shift[:, None, :]
        if l % 2 == 0:
            i = l // 2
            y = even_mixer(h, w_in_a[i], w_pool[i], pool_scale[i], q_norm_w[i], k_norm_w[i],
                           attn_sink[i], w_out_a[i])
        else:
            j = l // 2
            y = odd_mixer(h, w_in_c[j], w_gate_up[j], b_gate[j], gla_norm_w[j], w_out_c[j])
        x = x + gate[:, None, :] * y
    return x
```

```cpp
#include <hip/hip_runtime.h>
#include <hip/hip_cooperative_groups.h>
#include <cstdio>
namespace cg = cooperative_groups;

namespace pg8 {
#define PG8_LAS __attribute__((address_space(3)))
typedef unsigned short bf16_t;
typedef short bf16x8 __attribute__((ext_vector_type(8)));
typedef float f32x4 __attribute__((ext_vector_type(4)));
typedef unsigned u32x4 __attribute__((ext_vector_type(4)));
typedef unsigned u32x2 __attribute__((ext_vector_type(2)));
constexpr int BM = 256, BK = 64, HALF = 128, HTB = HALF * BK * 2  , STAGE_BYTES = 8 * HTB, NXCD = 8, WGM = 8;

__host__ __device__ __forceinline__ int lds_byte(int r, int c) { const int st = (r >> 4) * 2 + (c >> 5), rr = r & 15, cc = c & 31, ob = rr * 64 + cc * 2; return st * 1024 + (ob ^ (((ob >> 9) & 1) << 5)); }
__host__ __device__ __forceinline__ void stage_rc(int b, int& R, int& C) { const int st = b / 1024, sb = b % 1024, swz = sb ^ (((sb >> 9) & 1) << 5); R = (st >> 1) * 16 + swz / 64; C = (st & 1) * 32 + (swz % 64) / 2; }
__host__ __device__ __forceinline__ int perm32(int rho) { const int n = rho >> 4, i = rho & 15; return 8 * (i >> 2) + 4 * n + (i & 3); }

struct Unit { int pm, pn; };
struct Gemm { const bf16_t* A; const bf16_t* Bt; int M, N, K; };

struct StaticOrder {
    int nM, nN, nwg, G, c;
    __host__ __device__ void init(int M, int N, int G_, int c_) { nM = M / BM; nN = N / BM; nwg = nM * nN; G = G_; c = c_; }
    __host__ __device__ bool next(int i, Unit& u) const {
        const long L = (long)i * G + c; if (L >= nwg) return false;
        int wgid = (int)L; { const int q = nwg / NXCD, r = nwg % NXCD, xcd = wgid % NXCD, off = wgid / NXCD; wgid = (xcd < r ? xcd * (q + 1) : r * (q + 1) + (xcd - r) * q) + off; }
        const int nig = WGM * nN, gid = wgid / nig, fm = gid * WGM, gsz = (nM - fm) < WGM ? (nM - fm) : WGM;
        u.pm = fm + ((wgid % nig) % gsz); u.pn = (wgid % nig) / gsz; return true;
    }
    __device__ __forceinline__ void a_ready(const Unit&) const {}
    __device__ __forceinline__ void done(const Unit&) const {}
};

typedef __bf16 bf16v2_t __attribute__((ext_vector_type(2)));
typedef float f32v2_t __attribute__((ext_vector_type(2)));
__device__ __forceinline__ unsigned cvt_pk_bf16(float lo, float hi) { const f32v2_t v = {lo, hi}; const bf16v2_t b = __builtin_convertvector(v, bf16v2_t); return __builtin_bit_cast(unsigned, b); }
__device__ __forceinline__ unsigned short f2bf1(float f) { return (unsigned short)(cvt_pk_bf16(f, 0.f) & 0xffffu); }

struct EpiProj {
    static constexpr bool PERM = true, AFTER_DRAIN = false;
    bf16_t* O; int ldc; int ncols; bf16_t* VT; const float* rowss; const float* shw;
    __device__ __forceinline__ void operator()(const f32x4 (&acc)[2][2][4][2], const Unit& u, int wr, int wc, int fr, int fq) const {
        const int row0 = u.pm * BM + wr * 64 + fr, col0 = u.pn * BM + wc * 32 + 8 * fq;
        const bool dov = (VT != nullptr) && (u.pn == 6);
        const int vc = wc * 32 + 8 * fq, b = (u.pm * BM) >> 11;
        bf16_t* vbase = VT + ((size_t)((b * 2 + (vc >> 6)) * 64 + (vc & 63))) * 2048 + (row0 & 2047);
        f32x4 sh[2][2];
#pragma unroll
        for (int bj = 0; bj < 2; ++bj) { sh[bj][0] = *(const f32x4*)(shw + b * 3328 + col0 + bj * HALF); sh[bj][1] = *(const f32x4*)(shw + b * 3328 + col0 + bj * HALF + 4); }
        float rs[2][4];
#pragma unroll
        for (int ai = 0; ai < 2; ++ai)
#pragma unroll
            for (int m = 0; m < 4; ++m) rs[ai][m] = rowss[row0 + ai * HALF + m * 16];
#pragma unroll
        for (int ai = 0; ai < 2; ++ai)
#pragma unroll
            for (int m = 0; m < 4; ++m) { const int row = row0 + ai * HALF + m * 16; bf16_t* rowp = O + (size_t)row * ldc + col0;
                const float r = __builtin_amdgcn_rsqf(rs[ai][m] * (1.0f / 1024.0f) + 1e-6f);
#pragma unroll
                for (int bj = 0; bj < 2; ++bj) { const f32x4 v0 = acc[ai][bj][m][0] * r + sh[bj][0], v1 = acc[ai][bj][m][1] * r + sh[bj][1];
                    u32x4 w; w.x = cvt_pk_bf16(v0[0], v0[1]); w.y = cvt_pk_bf16(v0[2], v0[3]); w.z = cvt_pk_bf16(v1[0], v1[1]); w.w = cvt_pk_bf16(v1[2], v1[3]);
                    if (col0 + bj * HALF < ncols) *(u32x4*)(rowp + bj * HALF) = w;
                    if (bj == 1 && dov) { bf16_t* vp = vbase + ai * HALF + m * 16;
                        vp[0 * 2048] = (bf16_t)(w.x & 0xffffu); vp[1 * 2048] = (bf16_t)(w.x >> 16); vp[2 * 2048] = (bf16_t)(w.y & 0xffffu); vp[3 * 2048] = (bf16_t)(w.y >> 16);
                        vp[4 * 2048] = (bf16_t)(w.z & 0xffffu); vp[5 * 2048] = (bf16_t)(w.z >> 16); vp[6 * 2048] = (bf16_t)(w.w & 0xffffu); vp[7 * 2048] = (bf16_t)(w.w >> 16); } }
                asm volatile("" ::: "memory"); }
    }
};
struct EpiOut {
    static constexpr bool PERM = false, AFTER_DRAIN = false;
    const float* xin; float* xout; const float* gate;
    bf16_t* hp; const float* nwn; const float* scn; float* rssn;
    __device__ __forceinline__ void operator()(const f32x4 (&acc)[2][2][4][2], const Unit& u, int wr, int wc, int fr, int fq) const {
        const int row0 = u.pm * BM + wr * 64 + fr, col0 = u.pn * BM + wc * 32 + 4 * fq, b = (u.pm * BM) >> 11;
        const bool nx = hp != nullptr;
        f32x4 g[2][2], ws[2][2];
#pragma unroll
        for (int bj = 0; bj < 2; ++bj)
#pragma unroll
            for (int n = 0; n < 2; ++n) { const int c = col0 + bj * HALF + n * 16; g[bj][n] = *(const f32x4*)(gate + b * 3072 + c);
                ws[bj][n] = nx ? *(const f32x4*)(nwn + c) * (*(const f32x4*)(scn + b * 3072 + c) + 1.0f) : (f32x4){0.f, 0.f, 0.f, 0.f}; }
#pragma unroll
        for (int ai = 0; ai < 2; ++ai)
#pragma unroll
            for (int m = 0; m < 4; ++m) { const int row = row0 + ai * HALF + m * 16; const size_t off = (size_t)row * 1024 + col0; float ss = 0.f;
#pragma unroll
                for (int bj = 0; bj < 2; ++bj)
#pragma unroll
                    for (int n = 0; n < 2; ++n) { const f32x4 xo = *(const f32x4*)(xin + off + bj * HALF + n * 16); const f32x4 xn = xo + g[bj][n] * acc[ai][bj][m][n];
                        *(f32x4*)(xout + off + bj * HALF + n * 16) = xn;
                        if (nx) { ss += (xn[0] * xn[0] + xn[1] * xn[1]) + (xn[2] * xn[2] + xn[3] * xn[3]); const f32x4 h = xn * ws[bj][n];
                            u32x2 w; w.x = cvt_pk_bf16(h[0], h[1]); w.y = cvt_pk_bf16(h[2], h[3]); *(u32x2*)(hp + off + bj * HALF + n * 16) = w; } }
                if (nx) { ss += __shfl_xor(ss, 16); ss += __shfl_xor(ss, 32); if (fq == 0) atomicAdd(rssn + row, ss); }
                asm volatile("" ::: "memory"); }
    }
};

template <class Epi, class Sched, bool ALIGN_EPI = false, bool SP2 = false>
__device__ __forceinline__ void gemm_phase(PG8_LAS unsigned char* lds, const Gemm g, const Sched& S, const Epi& E) {
    int tid_ = threadIdx.x; asm volatile("" : "+v"(tid_));
    const int tid = tid_, wid = __builtin_amdgcn_readfirstlane(tid >> 6), lane = tid & 63, wr = wid >> 2, wc = wid & 3, fr = lane & 15, fq = lane >> 4;
    const int K = g.K, nt = K / BK;
    unsigned voffA[2], voffB[2];
#pragma unroll
    for (int i = 0; i < 2; ++i) { int R, C; stage_rc(tid * 16 + i * 8192, R, C); const int Rb = Epi::PERM ? ((R & ~31) + perm32(R & 31)) : R;
        voffA[i] = (unsigned)(R * K + C) * 2u; voffB[i] = (unsigned)(Rb * K + C) * 2u; }
    const size_t kstep = (size_t)(BK * 2);
    const size_t hstep = (size_t)HALF * K * 2;
    const size_t tstep = 2 * hstep;
    const unsigned ldsw = (unsigned)wid * 1024u;
    const int aoff = lds_byte(wr * 64 + fr, fq * 8), boff = lds_byte(wc * 32 + fr, fq * 8);
#define PG8_SA(b, h) (((b) * 2 + (h)) * HTB)
#define PG8_SB(b, h) ((4 + (b) * 2 + (h)) * HTB)
#define PG8_STAGE(bufoff, gbase, voff) do { _Pragma("unroll") for (int _i = 0; _i < 2; ++_i) \
        __builtin_amdgcn_global_load_lds((const unsigned*)((const char*)(gbase) + (voff)[_i]), (PG8_LAS unsigned*)(lds + (bufoff) + ldsw + _i * 8192), 16, 0, 0); } while (0)
#define PG8_LDA(dst, b, h) do { _Pragma("unroll") for (int m = 0; m < 4; ++m) _Pragma("unroll") for (int k = 0; k < 2; ++k) dst[m][k] = *(const PG8_LAS bf16x8*)(lds + PG8_SA(b, h) + aoff + m * 2048 + k * 1024); } while (0)
#define PG8_LDB(dst, b, h) do { _Pragma("unroll") for (int n = 0; n < 2; ++n) _Pragma("unroll") for (int k = 0; k < 2; ++k) dst[n][k] = *(const PG8_LAS bf16x8*)(lds + PG8_SB(b, h) + boff + n * 2048 + k * 1024); } while (0)
#define PG8_MMA(ai, bj, At, Bt) do { __builtin_amdgcn_s_setprio(1); _Pragma("unroll") for (int m = 0; m < 4; ++m) _Pragma("unroll") for (int n = 0; n < 2; ++n) _Pragma("unroll") for (int k = 0; k < 2; ++k) \
        acc[ai][bj][m][n] = __builtin_amdgcn_mfma_f32_16x16x32_bf16(Bt[n][k], At[m][k], acc[ai][bj][m][n], 0, 0, 0); __builtin_amdgcn_s_setprio(0); } while (0)
#define PG8_WAIT_V(n) asm volatile("s_waitcnt vmcnt(" #n ")" ::: "memory")
#define PG8_WAIT_L(n) asm volatile("s_waitcnt lgkmcnt(" #n ")" ::: "memory")
#define PG8_BAR __builtin_amdgcn_s_barrier()
#define PG8_SCHED __builtin_amdgcn_sched_barrier(0)
    Unit cur, nxt; int ui = 0;
    if (!S.next(0, cur)) return;
    f32x4 acc[2][2][4][2];
#pragma unroll
    for (int a = 0; a < 2; ++a)
#pragma unroll
        for (int b = 0; b < 2; ++b)
#pragma unroll
            for (int m = 0; m < 4; ++m)
#pragma unroll
                for (int n = 0; n < 2; ++n) acc[a][b][m][n] = (f32x4){0.f, 0.f, 0.f, 0.f};
    bf16x8 At[4][2], B0[2][2], B1[2][2];
    const char* cA = (const char*)g.A + (size_t)cur.pm * tstep; const char* cB = (const char*)g.Bt + (size_t)cur.pn * tstep;
    S.a_ready(cur);
    if constexpr (SP2) {
        PG8_STAGE(PG8_SB(0, 0), cB, voffB); PG8_STAGE(PG8_SB(0, 1), cB + hstep, voffB); PG8_STAGE(PG8_SA(0, 0), cA, voffA); PG8_STAGE(PG8_SA(0, 1), cA + hstep, voffA);
        if (wr == 1) PG8_BAR;
        PG8_WAIT_V(2); PG8_BAR;
        PG8_STAGE(PG8_SB(1, 0), cB + kstep, voffB); PG8_STAGE(PG8_SA(1, 0), cA + kstep, voffA); PG8_STAGE(PG8_SB(1, 1), cB + hstep + kstep, voffB);
        PG8_WAIT_V(6); PG8_BAR;
    } else {
        PG8_STAGE(PG8_SB(0, 0), cB, voffB); PG8_STAGE(PG8_SA(0, 0), cA, voffA); PG8_STAGE(PG8_SB(0, 1), cB + hstep, voffB); PG8_STAGE(PG8_SA(0, 1), cA + hstep, voffA);
        if (wr == 1) PG8_BAR;
        PG8_WAIT_V(4); PG8_BAR;
        PG8_STAGE(PG8_SB(1, 0), cB + kstep, voffB); PG8_STAGE(PG8_SA(1, 0), cA + kstep, voffA); PG8_STAGE(PG8_SB(1, 1), cB + hstep + kstep, voffB);
        PG8_WAIT_V(6); PG8_BAR;
    }
    for (;;) {
        const bool has_next = S.next(ui + 1, nxt);
        const char* nA = has_next ? (const char*)g.A + (size_t)nxt.pm * tstep : cA; const char* nB = has_next ? (const char*)g.Bt + (size_t)nxt.pn * tstep : cB;
        for (int t = 0; t < nt; t += 2) {
            const bool last = (t == nt - 2);
            const char* a1 = cA + (size_t)(t + 1) * kstep;
            const char* a2 = last ? nA : cA + (size_t)(t + 2) * kstep; const char* b2 = last ? nB : cB + (size_t)(t + 2) * kstep;
            const char* a3 = a2 + kstep; const char* b3 = b2 + kstep;
            if (last && has_next) S.a_ready(nxt);
            if constexpr (SP2) {
            PG8_LDB(B0, 0, 0); PG8_LDB(B1, 0, 1); PG8_SCHED; PG8_LDA(At, 0, 0); PG8_STAGE(PG8_SA(1, 1), a1 + hstep, voffA);
            PG8_WAIT_V(8); PG8_WAIT_L(0); PG8_BAR; PG8_MMA(0, 0, At, B0); PG8_MMA(0, 1, At, B1); PG8_BAR; PG8_SCHED;
            PG8_LDA(At, 0, 1); PG8_STAGE(PG8_SB(0, 0), b2, voffB); PG8_STAGE(PG8_SB(0, 1), b2 + hstep, voffB); PG8_STAGE(PG8_SA(0, 0), a2, voffA);
            PG8_WAIT_V(8); PG8_WAIT_L(0); PG8_BAR; PG8_MMA(1, 0, At, B0); PG8_MMA(1, 1, At, B1); PG8_BAR; PG8_SCHED;
            PG8_LDB(B0, 1, 0); PG8_LDB(B1, 1, 1); PG8_SCHED; PG8_LDA(At, 1, 0); PG8_STAGE(PG8_SA(0, 1), a2 + hstep, voffA);
            PG8_WAIT_V(8); PG8_WAIT_L(0); PG8_BAR; PG8_MMA(0, 0, At, B0); PG8_MMA(0, 1, At, B1); PG8_BAR; PG8_SCHED;
            PG8_LDA(At, 1, 1); PG8_STAGE(PG8_SB(1, 0), b3, voffB); PG8_STAGE(PG8_SB(1, 1), b3 + hstep, voffB); PG8_STAGE(PG8_SA(1, 0), a3, voffA);
            PG8_WAIT_V(8); PG8_WAIT_L(0); PG8_BAR; PG8_MMA(1, 0, At, B0); PG8_MMA(1, 1, At, B1); PG8_BAR; PG8_SCHED;
            } else {
            PG8_LDB(B0, 0, 0); PG8_SCHED; PG8_LDA(At, 0, 0); PG8_STAGE(PG8_SA(1, 1), a1 + hstep, voffA);
            PG8_WAIT_L(8); PG8_BAR; PG8_WAIT_L(0); PG8_MMA(0, 0, At, B0); PG8_BAR; PG8_SCHED;
            PG8_LDB(B1, 0, 1); PG8_STAGE(PG8_SB(0, 0), b2, voffB);
            PG8_BAR; PG8_WAIT_L(0); PG8_MMA(0, 1, At, B1); PG8_BAR;
            PG8_LDA(At, 0, 1); PG8_STAGE(PG8_SA(0, 0), a2, voffA);
            PG8_BAR; PG8_WAIT_L(0); PG8_MMA(1, 0, At, B0); PG8_BAR; PG8_SCHED;
            PG8_STAGE(PG8_SB(0, 1), b2 + hstep, voffB);
            PG8_WAIT_V(6); PG8_BAR; PG8_MMA(1, 1, At, B1); PG8_BAR;
            PG8_LDB(B0, 1, 0); PG8_SCHED; PG8_LDA(At, 1, 0); PG8_STAGE(PG8_SA(0, 1), a2 + hstep, voffA);
            PG8_WAIT_L(8); PG8_BAR; PG8_WAIT_L(0); PG8_MMA(0, 0, At, B0); PG8_BAR; PG8_SCHED;
            PG8_LDB(B1, 1, 1); PG8_STAGE(PG8_SB(1, 0), b3, voffB);
            PG8_BAR; PG8_WAIT_L(0); PG8_MMA(0, 1, At, B1); PG8_BAR;
            PG8_LDA(At, 1, 1); PG8_STAGE(PG8_SA(1, 0), a3, voffA);
            PG8_BAR; PG8_WAIT_L(0); PG8_MMA(1, 0, At, B0); PG8_BAR; PG8_SCHED;
            PG8_STAGE(PG8_SB(1, 1), b3 + hstep, voffB);
            PG8_WAIT_V(6); PG8_BAR; PG8_MMA(1, 1, At, B1); PG8_BAR;
            }
        }
        if constexpr (ALIGN_EPI) { if (wr == 0) PG8_BAR; }
        if constexpr (!Epi::AFTER_DRAIN) { E(acc, cur, wr, wc, fr, fq); S.done(cur); }
        if (!has_next) break;
#pragma unroll
        for (int a = 0; a < 2; ++a)
#pragma unroll
            for (int b = 0; b < 2; ++b)
#pragma unroll
                for (int m = 0; m < 4; ++m)
#pragma unroll
                    for (int n = 0; n < 2; ++n) acc[a][b][m][n] = (f32x4){0.f, 0.f, 0.f, 0.f};
        cur = nxt; cA = nA; cB = nB; ++ui;
        if constexpr (ALIGN_EPI) { if (wr == 1) PG8_BAR; }
    }
    PG8_WAIT_V(0);
    if constexpr (!ALIGN_EPI) { if (wr == 0) PG8_BAR; }
    PG8_BAR;
    if constexpr (Epi::AFTER_DRAIN) { E.fused(acc, cur, wr, wc, fr, fq, lds, wid, lane); S.done(cur); }
#undef PG8_SA
#undef PG8_SB
#undef PG8_STAGE
#undef PG8_LDA
#undef PG8_LDB
#undef PG8_MMA
#undef PG8_WAIT_V
#undef PG8_WAIT_L
#undef PG8_BAR
#undef PG8_SCHED
}
}

using pg8::bf16_t; using pg8::bf16x8; using pg8::f32x4; using pg8::u32x4; using pg8::cvt_pk_bf16; using pg8::f2bf1;
#define LAS __attribute__((address_space(3)))
using pg8::u32x2;
constexpr int D = 1024, NB = 32, SEQ = 2048, MTOK = NB * SEQ, DEPTH = 4;
constexpr int EVEN_IN = 2304, ODD_IN = 3104, ODD_INP = 3328;
constexpr int LDS_BYTES = 147456;
constexpr size_t MiB = 1u << 20;
constexpr size_t WS_MOD = 0;
constexpr size_t WS_WINA = 2 * MiB;
constexpr size_t WS_WOUTA = 12 * MiB;
constexpr size_t WS_WINC = 16 * MiB;
constexpr size_t WS_WOUTC = 30 * MiB;
constexpr size_t WS_WPT = 34 * MiB;
constexpr size_t WS_VT = 36 * MiB;
constexpr size_t WS_H = 64 * MiB;
constexpr size_t WS_OF = 192 * MiB;
constexpr size_t WS_OB = 320 * MiB;
constexpr size_t WS_PROJ = 448 * MiB;
constexpr size_t WS_HP = 840 * MiB;
constexpr size_t WS_ROWSS = 968 * MiB;
constexpr size_t WS_SHW = 970 * MiB;
constexpr size_t WS_SST = 972 * MiB;
constexpr size_t WS_END = 1004 * MiB;

__device__ __forceinline__ float bf2f(unsigned short b) { return __uint_as_float(((unsigned)b) << 16); }
__device__ __forceinline__ float bflo(unsigned w) { return __uint_as_float(w << 16); }
__device__ __forceinline__ float bfhi(unsigned w) { return __uint_as_float(w & 0xffff0000u); }
__device__ __forceinline__ float siluf(float z) { return z * __builtin_amdgcn_rcpf(1.0f + __builtin_amdgcn_exp2f(-1.4426950408889634f * z)); }
__device__ __forceinline__ f32x4 mfma16(bf16x8 a, bf16x8 b, f32x4 c) { return __builtin_amdgcn_mfma_f32_16x16x32_bf16(a, b, c, 0, 0, 0); }
__device__ __forceinline__ bf16x8 as_bf16x8(u32x4 v) { return __builtin_bit_cast(bf16x8, v); }

#define RLX_AGENT __ATOMIC_RELAXED, __HIP_MEMORY_SCOPE_AGENT
constexpr size_t WS_BAR = 1792 * 1024;
constexpr int LDS_MISC = 147456 - 64;
#define XB_TMO      128
#define XB_XCNT(j)  (256  + 64 * (j))
#define XB_XSUB(j)  (1280 + 64 * (j))
#define XB_XGEN(j)  (2304 + 64 * (j))
#define XB_TOP      3328
#define XB_TOPGEN   3392
#define XCD_BAR_WORDS 3456
#define XB_SPIN_CAP (1u << 18)

__device__ __forceinline__ unsigned xb_ld(unsigned* p)              { return __hip_atomic_load(p, __ATOMIC_RELAXED, __HIP_MEMORY_SCOPE_AGENT); }
__device__ __forceinline__ unsigned xb_add(unsigned* p, unsigned v) { return __hip_atomic_fetch_add(p, v, __ATOMIC_RELAXED, __HIP_MEMORY_SCOPE_AGENT); }
__device__ __forceinline__ unsigned xb_xcc_id() { return (unsigned)__builtin_amdgcn_s_getreg((3 << 11) | 20) & 0xFu; }
#define XB_SPIN(cond, bar) do { unsigned _sp = 0; while (cond) { __builtin_amdgcn_s_sleep(1); \
    if ((++_sp & 255u) == 0u) { if (xb_ld(&(bar)[XB_TMO])) break; if (_sp > XB_SPIN_CAP) { atomicAdd(&(bar)[XB_TMO], 1u); break; } } } } while (0)

struct XcdBarrier {
    unsigned* bar; unsigned x;
    volatile LAS unsigned* st;
};

__device__ __forceinline__ XcdBarrier xcd_barrier_post(unsigned* bar, volatile LAS unsigned* st) {
    XcdBarrier b; b.bar = bar; b.x = xb_xcc_id(); b.st = st;
    if (threadIdx.x == 0) (void)xb_add(&bar[XB_XCNT(b.x)], 1u);
    return b;
}
__device__ __forceinline__ void xcd_barrier_complete(unsigned* bar, unsigned x, unsigned& nloc, unsigned& nx) {
    const unsigned G = gridDim.x * gridDim.y * gridDim.z;
    unsigned sum, cnt, mine, sp = 0u;
    for (;;) {
        sum = 0u; cnt = 0u; mine = 0u;
#pragma unroll
        for (unsigned j = 0; j < 16; ++j) { const unsigned c = xb_ld(&bar[XB_XCNT(j)]); sum += c; cnt += (c > 0u) ? 1u : 0u; mine = (j == x) ? c : mine; }
        if (sum == G) break;
        __builtin_amdgcn_s_sleep(1);
        if ((++sp & 255u) == 0u) { if (xb_ld(&bar[XB_TMO])) break; if (sp > XB_SPIN_CAP) { atomicAdd(&bar[XB_TMO], 1u); break; } }
    }
    nloc = mine > 0u ? mine : 1u; nx = cnt > 0u ? cnt : 1u;
}

__device__ __forceinline__ void xcd_barrier(const XcdBarrier& b) {
    asm volatile("s_waitcnt vmcnt(0)" ::: "memory");
    __syncthreads();
    if (threadIdx.x == 0) {
        unsigned* bar = b.bar;
        __builtin_amdgcn_s_waitcnt(0);
        unsigned nloc = b.st[0], nx = b.st[1];
        if (nloc == 0u) { xcd_barrier_complete(bar, b.x, nloc, nx); b.st[0] = nloc; b.st[1] = nx; }
        const unsigned old = xb_add(&bar[XB_XSUB(b.x)], 1u);
        const unsigned gen = old / nloc;
        if (old + 1u == (gen + 1u) * nloc) {
            __builtin_amdgcn_fence(__ATOMIC_RELEASE, "agent");
            asm volatile("s_waitcnt vmcnt(0)" ::: "memory");
            const unsigned og = xb_add(&bar[XB_TOP], 1u);
            const unsigned tg = og / nx;
            if (og + 1u == (tg + 1u) * nx) xb_add(&bar[XB_TOPGEN], 1u);
            else XB_SPIN(xb_ld(&bar[XB_TOPGEN]) == tg, bar);
            __builtin_amdgcn_fence(__ATOMIC_ACQUIRE, "agent");
            xb_add(&bar[XB_XGEN(b.x)], 1u);
            asm volatile("s_waitcnt vmcnt(0)" ::: "memory");
        } else {
            XB_SPIN(xb_ld(&bar[XB_XGEN(b.x)]) == gen, bar);
            __builtin_amdgcn_fence(__ATOMIC_ACQUIRE, "agent");
            asm volatile("s_waitcnt vmcnt(0)" ::: "memory");
        }
    }
    __syncthreads();
}

#ifndef GEMM_SP2
#define GEMM_SP2 true
#endif
#ifndef GEMM_ALIGN
#define GEMM_ALIGN true
#endif
struct Ctx { int tid, lane, wid, vcu, G; };

__device__ __forceinline__ void small_gemm_item(LAS unsigned char* lds, const Ctx& X, const float* src, int srcS, bool use_silu, const float* W, int ldw, int ncols, int n0, const float* bias, float* out, int outS) {
    LAS float* SC = (LAS float*)lds;
    __syncthreads();
#pragma unroll
    for (int it = 0; it < 16; ++it) { const int t = X.tid + 512 * it, b = t >> 8, k4 = t & 255; f32x4 v = *(const f32x4*)(src + (size_t)b * srcS + 4 * k4);
        if (use_silu) { v[0] = siluf(v[0]); v[1] = siluf(v[1]); v[2] = siluf(v[2]); v[3] = siluf(v[3]); }
        *(LAS f32x4*)(SC + b * 1024 + 4 * k4) = v; }
    __syncthreads();
    float acc[32];
#pragma unroll
    for (int b = 0; b < 32; ++b) acc[b] = 0.f;
    const int nc = (n0 + X.lane < ncols) ? n0 + X.lane : ncols - 1;
    const float* wp = W + (size_t)(X.wid * 128) * ldw + nc;
#pragma unroll 4
    for (int k = 0; k < 128; k += 4) { const float w0 = wp[(size_t)k * ldw], w1 = wp[(size_t)(k + 1) * ldw], w2 = wp[(size_t)(k + 2) * ldw], w3 = wp[(size_t)(k + 3) * ldw];
#pragma unroll
        for (int b = 0; b < 32; ++b) { const f32x4 s4 = *(const LAS f32x4*)(SC + b * 1024 + X.wid * 128 + k); acc[b] += (s4[0] * w0 + s4[1] * w1) + (s4[2] * w2 + s4[3] * w3); } }
    __syncthreads();
    LAS float* RED = (LAS float*)lds;
#pragma unroll
    for (int b = 0; b < 32; ++b) RED[(X.wid * 32 + b) * 64 + X.lane] = acc[b];
    __syncthreads();
    for (int o = X.tid; o < 2048; o += 512) { const int b = o >> 6, nn = o & 63; float sv = bias ? bias[n0 + nn < ncols ? n0 + nn : ncols - 1] : 0.f;
#pragma unroll
        for (int w = 0; w < 8; ++w) sv += RED[(w * 32 + b) * 64 + nn];
        if (n0 + nn < ncols) out[(size_t)b * outS + n0 + nn] = sv; }
}
__device__ __forceinline__ void mod_phase(LAS unsigned char* lds, const Ctx& X, const float* c, const float* w_ada, const float* b_ada, float* mod) {
    for (int item = X.vcu; item < 192; item += X.G) { const int l = item / 48, n0 = (item % 48) * 64;
        small_gemm_item(lds, X, c, 1024, true, w_ada + (size_t)l * 1024 * 3072, 3072, 3072, n0, b_ada + l * 3072, mod + (size_t)l * 32 * 3072, 3072); }
    __syncthreads();
}
__device__ __forceinline__ void shiftw_phase(LAS unsigned char* lds, const Ctx& X, const float* mod, const float* w_in_a, const float* w_in_c, float* shw) {
    for (int item = X.vcu; item < 170; item += X.G) {
        int l, j; if (item < 36) { l = 0; j = item; } else if (item < 85) { l = 1; j = item - 36; } else if (item < 121) { l = 2; j = item - 85; } else { l = 3; j = item - 121; }
        const bool odd = (l & 1) != 0; const int N = odd ? ODD_IN : EVEN_IN;
        const float* W = odd ? w_in_c + (size_t)(l >> 1) * 1024 * ODD_IN : w_in_a + (size_t)(l >> 1) * 1024 * EVEN_IN;
        small_gemm_item(lds, X, mod + (size_t)l * 32 * 3072, 3072, false, W, N, N, j * 64, nullptr, shw + (size_t)l * 32 * 3328, 3328); }
    __syncthreads();
}

__device__ __forceinline__ void transpose_item(const float* W, int K, int N, bf16_t* WT, LAS float* scr, int item, int lane) {
    const int nblk = N / 32, kb = item / nblk, nb = item % nblk, k0 = 64 * kb, n0 = 32 * nb;
#pragma unroll 8
    for (int i = 0; i < 32; ++i) { const int kk = 2 * i + (lane >> 5); scr[kk * 33 + (lane & 31)] = W[(size_t)(k0 + kk) * N + n0 + (lane & 31)]; }
    asm volatile("s_waitcnt lgkmcnt(0)" ::: "memory");
    const int c = lane & 7;
#pragma unroll
    for (int j = 0; j < 4; ++j) { const int n = (lane >> 3) + 8 * j; const LAS float* s = scr + (8 * c) * 33 + n;
        u32x4 o; o.x = cvt_pk_bf16(s[0 * 33], s[1 * 33]); o.y = cvt_pk_bf16(s[2 * 33], s[3 * 33]); o.z = cvt_pk_bf16(s[4 * 33], s[5 * 33]); o.w = cvt_pk_bf16(s[6 * 33], s[7 * 33]);
        *(u32x4*)(WT + (size_t)(n0 + n) * K + k0 + 8 * c) = o; }
    asm volatile("s_waitcnt lgkmcnt(0)" ::: "memory");
}
struct WPtrs { const float *w_in_a, *w_out_a, *w_in_c, *w_out_c, *w_pool; };
__device__ __forceinline__ void transpose_phase(LAS unsigned char* lds, const Ctx& X, const WPtrs& P, unsigned char* ws) {
    LAS float* scr = (LAS float*)(lds + X.wid * 16384);
    const int gw = X.vcu * 8 + X.wid, NGW = X.G * 8;
    constexpr int I_INA = 16 * 72, I_OUT = 16 * 32, I_INC = 16 * 97, I_POOL = 2 * 4;
    constexpr int NITEMS = 2 * I_INA + 2 * I_OUT + 2 * I_INC + 2 * I_OUT + 8 * I_POOL;
    for (int it = gw; it < NITEMS; it += NGW) {
        int r = it;
        if (r < 2 * I_INA) { const int i = r / I_INA; transpose_item(P.w_in_a + (size_t)i * 1024 * EVEN_IN, 1024, EVEN_IN, (bf16_t*)(ws + WS_WINA) + (size_t)i * EVEN_IN * 1024, scr, r % I_INA, X.lane); continue; } r -= 2 * I_INA;
        if (r < 2 * I_OUT) { const int i = r / I_OUT; transpose_item(P.w_out_a + (size_t)i * 1024 * 1024, 1024, 1024, (bf16_t*)(ws + WS_WOUTA) + (size_t)i * 1024 * 1024, scr, r % I_OUT, X.lane); continue; } r -= 2 * I_OUT;
        if (r < 2 * I_INC) { const int i = r / I_INC; transpose_item(P.w_in_c + (size_t)i * 1024 * ODD_IN, 1024, ODD_IN, (bf16_t*)(ws + WS_WINC) + (size_t)i * ODD_INP * 1024, scr, r % I_INC, X.lane); continue; } r -= 2 * I_INC;
        if (r < 2 * I_OUT) { const int i = r / I_OUT; transpose_item(P.w_out_c + (size_t)i * 1024 * 1024, 1024, 1024, (bf16_t*)(ws + WS_WOUTC) + (size_t)i * 1024 * 1024, scr, r % I_OUT, X.lane); continue; } r -= 2 * I_OUT;
        { const int i = r / I_POOL; transpose_item(P.w_pool + (size_t)i * 16384, 128, 128, (bf16_t*)(ws + WS_WPT) + (size_t)i * 16384, scr, r % I_POOL, X.lane); }
    }
    for (int t = (X.vcu * 512 + X.tid); t < 2 * 224 * 128; t += X.G * 512) { const int i = t / (224 * 128), rr = t % (224 * 128);
        *(u32x4*)((bf16_t*)(ws + WS_WINC) + ((size_t)i * ODD_INP + ODD_IN) * 1024 + (size_t)rr * 8) = (u32x4){0u, 0u, 0u, 0u}; }
}

__device__ __forceinline__ float wave_sum(float v) {
#pragma unroll
    for (int o = 1; o < 64; o <<= 1) v += __shfl_xor(v, o);
    return v;
}
__device__ __forceinline__ void prenorm_phase(const Ctx& X, const float* x, const float* nw, const float* modl, bf16_t* hp, float* rowss) {
    const int gw = X.vcu * 8 + X.wid, NGW = X.G * 8;
    for (int m = gw; m < MTOK; m += NGW) {
        const int b = m >> 11;
        const f32x4* xr = (const f32x4*)(x + (size_t)m * D) + X.lane;
        f32x4 v[4]; float s = 0.f;
#pragma unroll
        for (int j = 0; j < 4; ++j) { v[j] = xr[64 * j]; s += (v[j][0] * v[j][0] + v[j][1] * v[j][1]) + (v[j][2] * v[j][2] + v[j][3] * v[j][3]); }
        s = wave_sum(s); if (X.lane == 0) rowss[m] = s;
        const f32x4* nwp = (const f32x4*)nw + X.lane; const f32x4* scp = (const f32x4*)(modl + b * 3072 + 1024) + X.lane;
        u32x2* o8 = (u32x2*)(hp + (size_t)m * D) + X.lane;
#pragma unroll
        for (int j = 0; j < 4; ++j) { const f32x4 y = v[j] * nwp[64 * j] * (scp[64 * j] + 1.0f);
            u32x2 o; o.x = cvt_pk_bf16(y[0], y[1]); o.y = cvt_pk_bf16(y[2], y[3]); o8[64 * j] = o; }
    }
}

__device__ __forceinline__ int recency_tile(int jt) { const int jp = jt >> 1, pm = ((jp >> 3) & 7) * 32 + (3 - (jp >> 6)) * 8 + (jp & 7); return 2 * pm + (jt & 1); }
template <int HW> __device__ __forceinline__ void pool_window(LAS unsigned char* lds, int U_OFF, int P_OFF, int US, int tid, int s0) {
    const int cp = tid & 63, t0 = 16 * (tid >> 6);
    constexpr int NR = 16 + 2 * HW - 1;
    unsigned rw[NR];
#pragma unroll
    for (int k = 0; k < NR; ++k) rw[k] = *(const LAS unsigned*)(lds + U_OFF + (t0 + 8 - HW + k) * US + cp * 4);
    float a0 = 0.f, a1 = 0.f;
#pragma unroll
    for (int k = 0; k < 2 * HW; ++k) { a0 += bflo(rw[k]); a1 += bfhi(rw[k]); }
#pragma unroll
    for (int it = 0; it < 16; ++it) { const int s = s0 + t0 + it;
        if (it > 0) { a0 += bflo(rw[2 * HW - 1 + it]) - bflo(rw[it - 1]); a1 += bfhi(rw[2 * HW - 1 + it]) - bfhi(rw[it - 1]); }
        int lo = s - HW, hi = s + HW - 1; lo = lo < 0 ? 0 : lo; hi = hi > SEQ - 1 ? SEQ - 1 : hi; const float inv = __builtin_amdgcn_rcpf((float)(hi - lo + 1));
        const unsigned uc = rw[HW + it];
        *(LAS unsigned*)(lds + P_OFF + (t0 + it) * US + cp * 4) = cvt_pk_bf16(a0 * inv - bflo(uc), a1 * inv - bfhi(uc)); }
}
__device__ __forceinline__ void pool_phase(LAS unsigned char* lds, const Ctx& X, const bf16_t* proj, const bf16_t* WpT, const float* pscale, bf16_t* mix) {
    constexpr int US = 272, U_OFF = 0, P_OFF = 144 * US, W_OFF = P_OFF + 128 * US;
    const int tid = X.tid, fr = X.lane & 15, fq = X.lane >> 4;
    u32x4 pu[5];
#define POOL_LOADU(item_) do { const int g_ = (item_) & 3, tt_ = recency_tile((item_) >> 2), row0_ = tt_ * 128, b_ = row0_ >> 11, s0_ = row0_ & 2047; \
        _Pragma("unroll") for (int it = 0; it < 5; ++it) { const int t = tid + 512 * it, rr = t >> 4, pc = t & 15, s = s0_ - 8 + rr; pu[it] = (u32x4){0u, 0u, 0u, 0u}; \
            if (t < 144 * 16 && s >= 0 && s < SEQ) pu[it] = *(const u32x4*)(proj + ((size_t)b_ * SEQ + s) * EVEN_IN + g_ * 128 + pc * 8); } } while (0)
    if (X.vcu < 2048) POOL_LOADU(X.vcu);
    for (int item = X.vcu; item < 2048; item += X.G) {
        const int g = item & 3, tt = recency_tile(item >> 2), row0 = tt * 128, s0 = row0 & 2047;
        const size_t tok = (size_t)row0 + 16 * X.wid + fr;
        u32x2 zr[8];
#pragma unroll
        for (int df = 0; df < 8; ++df) zr[df] = *(const u32x2*)(proj + tok * EVEN_IN + 512 + g * 128 + 16 * df + 4 * fq);
        u32x4 wv[4];
#pragma unroll
        for (int it = 0; it < 4; ++it) { const int t = tid + 512 * it, d = t >> 4, pc = t & 15; wv[it] = *(const u32x4*)(WpT + (size_t)g * 16384 + d * 128 + pc * 8); }
        __syncthreads();
#pragma unroll
        for (int it = 0; it < 5; ++it) { const int t = tid + 512 * it, rr = t >> 4, pc = t & 15; if (t < 144 * 16) *(LAS u32x4*)(lds + U_OFF + rr * US + pc * 16) = pu[it]; }
#pragma unroll
        for (int it = 0; it < 4; ++it) { const int t = tid + 512 * it, d = t >> 4, pc = t & 15; *(LAS u32x4*)(lds + W_OFF + d * US + pc * 16) = wv[it]; }
        { const int nxt = item + X.G < 2048 ? item + X.G : item; POOL_LOADU(nxt); }
        __syncthreads();
        if (g == 0) pool_window<1>(lds, U_OFF, P_OFF, US, tid, s0); else if (g == 1) pool_window<2>(lds, U_OFF, P_OFF, US, tid, s0);
        else if (g == 2) pool_window<4>(lds, U_OFF, P_OFF, US, tid, s0); else pool_window<8>(lds, U_OFF, P_OFF, US, tid, s0);
        __syncthreads();
        f32x4 acc[8];
#pragma unroll
        for (int df = 0; df < 8; ++df) acc[df] = (f32x4){0.f, 0.f, 0.f, 0.f};
#pragma unroll
        for (int ks = 0; ks < 4; ++ks) { const bf16x8 pb = *(const LAS bf16x8*)(lds + P_OFF + (16 * X.wid + fr) * US + ks * 64 + fq * 16);
#pragma unroll
            for (int df = 0; df < 8; ++df) { const bf16x8 wa = *(const LAS bf16x8*)(lds + W_OFF + (16 * df + fr) * US + ks * 64 + fq * 16); acc[df] = mfma16(wa, pb, acc[df]); } }
#pragma unroll
        for (int df = 0; df < 8; ++df) { const int c = g * 128 + 16 * df + 4 * fq; const f32x4 ps = *(const f32x4*)(pscale + c); const u32x2 z = zr[df];
            u32x2 o; o.x = cvt_pk_bf16(acc[df][0] * ps[0] * siluf(bflo(z.x)), acc[df][1] * ps[1] * siluf(bfhi(z.x))); o.y = cvt_pk_bf16(acc[df][2] * ps[2] * siluf(bflo(z.y)), acc[df][3] * ps[3] * siluf(bfhi(z.y)));
            *(u32x2*)(mix + tok * 1024 + c) = o; }
    }
#undef POOL_LOADU
    __syncthreads();
}

__device__ __forceinline__ void attn_phase(LAS unsigned char* lds, const Ctx& X, const bf16_t* proj, const bf16_t* VTg, const float* qw, const float* kw, const float* sink, bf16_t* mix) {
    constexpr int KS = 144, VS = 816, V_OFF = 384 * KS;
    const int tid = X.tid, wid = X.wid;
    for (int item = X.vcu; item < 1024; item += X.G) {
        const int kvh = item & 1, tile = recency_tile(item >> 1), qb = tile & 15, b = tile >> 4, q0 = qb * 128; const size_t rowbase = (size_t)b * SEQ;
        __syncthreads();
#pragma unroll
        for (int it = 0; it < 6; ++it) { const int t = tid + 512 * it, jj = t >> 3, pc = t & 7, kpos = q0 - 128 + jj; u32x4 raw = (u32x4){0u, 0u, 0u, 0u};
            if (kpos >= 0 && kpos < SEQ) raw = *(const u32x4*)(proj + (rowbase + kpos) * EVEN_IN + 1536 + kvh * 64 + pc * 8);
            float f[8]; f[0] = bflo(raw.x); f[1] = bfhi(raw.x); f[2] = bflo(raw.y); f[3] = bfhi(raw.y); f[4] = bflo(raw.z); f[5] = bfhi(raw.z); f[6] = bflo(raw.w); f[7] = bfhi(raw.w);
            float ss = 0.f;
#pragma unroll
            for (int e = 0; e < 8; ++e) ss += f[e] * f[e];
            ss += __shfl_xor(ss, 1); ss += __shfl_xor(ss, 2); ss += __shfl_xor(ss, 4);
            const float r = 1.0f / sqrtf(ss * (1.f / 64.f) + 1e-6f);
            const f32x4 w0 = *(const f32x4*)(kw + pc * 8), w1 = *(const f32x4*)(kw + pc * 8 + 4);
            u32x4 o; o.x = cvt_pk_bf16(f[0] * r * w0[0], f[1] * r * w0[1]); o.y = cvt_pk_bf16(f[2] * r * w0[2], f[3] * r * w0[3]); o.z = cvt_pk_bf16(f[4] * r * w1[0], f[5] * r * w1[1]); o.w = cvt_pk_bf16(f[6] * r * w1[2], f[7] * r * w1[3]);
            *(LAS u32x4*)(lds + jj * KS + pc * 16) = o; }
#pragma unroll
        for (int it = 0; it < 7; ++it) { const int t = tid + 512 * it, d = t / 50, pc = t % 50, jj0 = pc * 8, kpos0 = q0 - 128 + jj0; u32x4 v = (u32x4){0u, 0u, 0u, 0u};
            if (t < 64 * 50 && jj0 < 384 && kpos0 >= 0 && kpos0 < SEQ) v = *(const u32x4*)(VTg + ((size_t)((b * 2 + kvh) * 64 + d)) * 2048 + kpos0);
            if (t < 64 * 50) *(LAS u32x4*)(lds + V_OFF + d * VS + pc * 16) = v; }
        __syncthreads();
        const int hq = kvh * 4 + (wid >> 1), qh = wid & 1;
        const float L2E = 1.4426950408889634f;
        const float slope2 = exp2f(-(float)(hq + 1)) * L2E, sink2 = sink[hq] * L2E;
        u32x4 qr0, qr1; u32x2 zr[4];
#define ATT_LOADQ(qf_) do { int l_ = X.lane; asm volatile("" : "+v"(l_)); const size_t tq_ = rowbase + q0 + (qh * 4 + (qf_)) * 16 + (l_ & 15); \
            const bf16_t* qp_ = proj + tq_ * EVEN_IN + 1024 + hq * 64 + (l_ >> 4) * 8; qr0 = *(const u32x4*)qp_; qr1 = *(const u32x4*)(qp_ + 32); \
            _Pragma("unroll") for (int df = 0; df < 4; ++df) zr[df] = *(const u32x2*)(proj + tq_ * EVEN_IN + 1792 + hq * 64 + 16 * df + 4 * (l_ >> 4)); } while (0)
        ATT_LOADQ(0);
#pragma unroll 1
        for (int qf = 0; qf < 4; ++qf) {
            int ln = X.lane; asm volatile("" : "+v"(ln)); const int fr = ln & 15, fq = ln >> 4;
            const int qfi = qh * 4 + qf, qo = qfi * 16; const size_t tq = rowbase + q0 + qo + fr;
            bf16x8 Q0, Q1; u32x2 zc[4];
            { const u32x4 r0 = qr0, r1 = qr1;
#pragma unroll
              for (int df = 0; df < 4; ++df) zc[df] = zr[df];
              float f[16]; f[0] = bflo(r0.x); f[1] = bfhi(r0.x); f[2] = bflo(r0.y); f[3] = bfhi(r0.y); f[4] = bflo(r0.z); f[5] = bfhi(r0.z); f[6] = bflo(r0.w); f[7] = bfhi(r0.w);
              f[8] = bflo(r1.x); f[9] = bfhi(r1.x); f[10] = bflo(r1.y); f[11] = bfhi(r1.y); f[12] = bflo(r1.z); f[13] = bfhi(r1.z); f[14] = bflo(r1.w); f[15] = bfhi(r1.w);
              float ss = 0.f;
#pragma unroll
              for (int e = 0; e < 16; ++e) ss += f[e] * f[e];
              ss += __shfl_xor(ss, 16); ss += __shfl_xor(ss, 32);
              const float r = (0.125f * L2E) * __builtin_amdgcn_rsqf(ss * (1.f / 64.f) + 1e-6f);
              const f32x4 wa = *(const f32x4*)(qw + fq * 8), wb = *(const f32x4*)(qw + fq * 8 + 4), wc_ = *(const f32x4*)(qw + 32 + fq * 8), wd = *(const f32x4*)(qw + 32 + fq * 8 + 4);
              u32x4 a, c2;
              a.x = cvt_pk_bf16(f[0] * r * wa[0], f[1] * r * wa[1]); a.y = cvt_pk_bf16(f[2] * r * wa[2], f[3] * r * wa[3]); a.z = cvt_pk_bf16(f[4] * r * wb[0], f[5] * r * wb[1]); a.w = cvt_pk_bf16(f[6] * r * wb[2], f[7] * r * wb[3]);
              c2.x = cvt_pk_bf16(f[8] * r * wc_[0], f[9] * r * wc_[1]); c2.y = cvt_pk_bf16(f[10] * r * wc_[2], f[11] * r * wc_[3]); c2.z = cvt_pk_bf16(f[12] * r * wd[0], f[13] * r * wd[1]); c2.w = cvt_pk_bf16(f[14] * r * wd[2], f[15] * r * wd[3]);
              Q0 = as_bf16x8(a); Q1 = as_bf16x8(c2); }
            ATT_LOADQ(qf < 3 ? qf + 1 : 3);
            f32x4 s[17];
#pragma unroll
            for (int kf = 0; kf < 17; ++kf) { const LAS unsigned char* kp = lds + ((qfi + kf) * 16 + fr) * KS + fq * 16;
                f32x4 a = (f32x4){0.f, 0.f, 0.f, 0.f}; a = mfma16(*(const LAS bf16x8*)kp, Q0, a); a = mfma16(*(const LAS bf16x8*)(kp + 64), Q1, a); s[kf] = a; }
            const int posq = q0 + qo + fr; const float tf = (float)(4 * fq - fr);
            const float lo = fmaxf(-128.f, -(float)posq), hi = fminf(128.f, (float)(SEQ - 1 - posq));
            float mx = sink2;
            if (qb == 0 || qb == 15) {
#pragma unroll
                for (int kf = 0; kf < 17; ++kf)
#pragma unroll
                    for (int e = 0; e < 4; ++e) { const float d = tf + (float)(16 * kf + e - 128); const bool valid = (d >= lo) && (d <= hi);
                        const float v = valid ? s[kf][e] - slope2 * fabsf(d) : -1e30f; s[kf][e] = v; mx = fmaxf(mx, v); }
            } else {
#pragma unroll
                for (int kf = 0; kf < 17; ++kf)
#pragma unroll
                    for (int e = 0; e < 4; ++e) { const float d = tf + (float)(16 * kf + e - 128); float v = s[kf][e] - slope2 * fabsf(d);
                        if (kf == 0) v = (d >= -128.f) ? v : -1e30f;
                        if (kf == 16) v = (d <= 128.f) ? v : -1e30f;
                        s[kf][e] = v; mx = fmaxf(mx, v); }
            }
            mx = fmaxf(mx, __shfl_xor(mx, 16)); mx = fmaxf(mx, __shfl_xor(mx, 32));
            float sum = 0.f;
#pragma unroll
            for (int kf = 0; kf < 17; ++kf)
#pragma unroll
                for (int e = 0; e < 4; ++e) { const float p = __builtin_amdgcn_exp2f(s[kf][e] - mx); s[kf][e] = p; sum += p; }
            sum += __shfl_xor(sum, 16); sum += __shfl_xor(sum, 32);
            const float inv = __builtin_amdgcn_rcpf(sum + __builtin_amdgcn_exp2f(sink2 - mx));
            f32x4 o[4];
#pragma unroll
            for (int df = 0; df < 4; ++df) o[df] = (f32x4){0.f, 0.f, 0.f, 0.f};
#pragma unroll
            for (int kp = 0; kp < 9; ++kp) { u32x4 pb; pb.x = cvt_pk_bf16(s[2 * kp][0], s[2 * kp][1]); pb.y = cvt_pk_bf16(s[2 * kp][2], s[2 * kp][3]);
                if (kp < 8) { pb.z = cvt_pk_bf16(s[(2 * kp + 1) % 17][0], s[(2 * kp + 1) % 17][1]); pb.w = cvt_pk_bf16(s[(2 * kp + 1) % 17][2], s[(2 * kp + 1) % 17][3]); } else { pb.z = 0u; pb.w = 0u; }
                const bf16x8 P = as_bf16x8(pb);
#pragma unroll
                for (int df = 0; df < 4; ++df) { const LAS unsigned char* vp = lds + V_OFF + (16 * df + fr) * VS + ((qfi + 2 * kp) * 16 + 4 * fq) * 2;
                    const u32x2 lo2 = *(const LAS u32x2*)vp, hi2 = *(const LAS u32x2*)(vp + 32); u32x4 va; va.x = lo2.x; va.y = lo2.y; va.z = hi2.x; va.w = hi2.y;
                    o[df] = mfma16(as_bf16x8(va), P, o[df]); } }
#pragma unroll
            for (int df = 0; df < 4; ++df) { const int c = hq * 64 + 16 * df + 4 * fq; const u32x2 z = zc[df];
                u32x2 ov; ov.x = cvt_pk_bf16(o[df][0] * inv * siluf(bflo(z.x)), o[df][1] * inv * siluf(bfhi(z.x))); ov.y = cvt_pk_bf16(o[df][2] * inv * siluf(bflo(z.y)), o[df][3] * inv * siluf(bfhi(z.y)));
                *(u32x2*)(mix + tq * 1024 + 512 + c) = ov; }
        }
#undef ATT_LOADQ
    }
    __syncthreads();
}

template <int CTRL> __device__ __forceinline__ float dpp_f32(float v) { return __builtin_bit_cast(float, __builtin_amdgcn_update_dpp(0, __builtin_bit_cast(int, v), CTRL, 0xf, 0xf, false)); }
__device__ __forceinline__ void gla_phase(LAS unsigned char* lds, const Ctx& X, const bf16_t* proj, const float* Wg, const float* bg, bf16_t* OF, bf16_t* OB, float* SST, bool ph2, const float* gw, bf16_t* mix) {
    constexpr int RS = 272, TS = 144;
    constexpr int QA = 0, KA = 64 * RS, QX = 2 * 64 * RS, KXT = 3 * 64 * RS, VT = KXT + 128 * TS, ATT = VT + 256 * TS, DEC = ATT + 64 * TS, AW = DEC + 512, PART = AW + 2048;
    static_assert(PART + 2048 <= 147392, "gla lds");
    const int wid = X.wid;
    const float sc = 0.08838834764831845f;
    for (int item = X.vcu; item < 256; item += X.G) {
        const int half = item & 1, hd = (item >> 1) & 3, b = item >> 3, dir = ph2 ? 1 - half : half;
        bf16_t* obuf = dir ? OB : OF; const bf16_t* other = dir ? OF : OB;
        float* sst = SST + ((size_t)((b * 4 + hd) * 2 + dir)) * 32768 + (size_t)wid * 4096;
#define CHUNK(n_) (ph2 ? (dir ? 15 - (n_) : 16 + (n_)) : (dir ? 31 - (n_) : (n_)))
        __syncthreads();
        bf16x8 WgA;
        { const int fr_ = X.lane & 15, fq_ = X.lane >> 4; float wv[8];
#pragma unroll
          for (int j = 0; j < 8; ++j) wv[j] = (fq_ < 2) ? Wg[(size_t)(dir * 16 + 8 * (fq_ & 1) + j) * 512 + hd * 128 + 16 * wid + fr_] : 0.f;
          u32x4 p; p.x = cvt_pk_bf16(wv[0], wv[1]); p.y = cvt_pk_bf16(wv[2], wv[3]); p.z = cvt_pk_bf16(wv[4], wv[5]); p.w = cvt_pk_bf16(wv[6], wv[7]); WgA = as_bf16x8(p); }
        const f32x4 bgv = *(const f32x4*)(bg + dir * 512 + hd * 128 + 16 * wid + 4 * (X.lane >> 4));
        f32x4 S[8][2];
#pragma unroll
        for (int kf = 0; kf < 8; ++kf)
#pragma unroll
            for (int vf = 0; vf < 2; ++vf) S[kf][vf] = ph2 ? *(const f32x4*)(sst + ((kf * 2 + vf) * 64 + X.lane) * 4) : (f32x4){0.f, 0.f, 0.f, 0.f};
        u32x4 pa1 = (u32x4){0u, 0u, 0u, 0u}, raq[2], rak[2]; u32x2 pv[2][4];
#define TOKC(cc, i) ((size_t)b * SEQ + (size_t)(cc) * 64 + (size_t)(dir ? 63 - (i) : (i)))
#define GLA_LOADS(cc) do { int tl = X.tid; asm volatile("" : "+v"(tl)); const int l_ = tl & 63, rbl_ = l_ & 3, cql_ = l_ >> 2; \
            if (tl < 128) pa1 = *(const u32x4*)(proj + TOKC(cc, tl >> 1) * ODD_IN + 3072 + dir * 16 + (tl & 1) * 8); \
            _Pragma("unroll") for (int t = 0; t < 2; ++t) { const int pi = tl + 512 * t; const bf16_t* pp = proj + TOKC(cc, pi >> 4) * ODD_IN + hd * 128 + (pi & 15) * 8; raq[t] = *(const u32x4*)pp; rak[t] = *(const u32x4*)(pp + 512); } \
            _Pragma("unroll") for (int p = 0; p < 2; ++p) { const int ps = 2 * wid + p, rbg = ps >> 2, cg = ps & 3; \
                _Pragma("unroll") for (int r = 0; r < 4; ++r) pv[p][r] = *(const u32x2*)(proj + TOKC(cc, 4 * (4 * rbg + rbl_) + r) * ODD_IN + 1024 + hd * 256 + 4 * (16 * cg + cql_)); } } while (0)
#define GLA_STAGE_A() do { int tl = X.tid; asm volatile("" : "+v"(tl)); if (tl < 128) *(LAS u32x4*)(lds + AW + (tl >> 1) * 32 + (tl & 1) * 16) = pa1; } while (0)
#define GLA_STAGE_QK() do { int tl = X.tid; asm volatile("" : "+v"(tl)); _Pragma("unroll") for (int t = 0; t < 2; ++t) { const int pi = tl + 512 * t; \
            *(LAS u32x4*)(lds + QA + (pi >> 4) * RS + (pi & 15) * 16) = raq[t]; *(LAS u32x4*)(lds + KA + (pi >> 4) * RS + (pi & 15) * 16) = rak[t]; } } while (0)
        GLA_LOADS(CHUNK(0));
        GLA_STAGE_A(); GLA_STAGE_QK();
        __syncthreads();
#pragma unroll 1
        for (int n = 0; n < 16; ++n) {
            const int c = CHUNK(n); const int nn = n < 15 ? n + 1 : 15, cnx = CHUNK(nn);
            int tid = X.tid; asm volatile("" : "+v"(tid)); const int lane = tid & 63, fr = lane & 15, fq = lane >> 4, rb = fr, cs = fq;
            u32x2 pq[4], pk[4];
#pragma unroll
            for (int r = 0; r < 4; ++r) { const int ro = (4 * rb + r) * RS + (16 * wid + 4 * cs) * 2; pq[r] = *(const LAS u32x2*)(lds + QA + ro); pk[r] = *(const LAS u32x2*)(lds + KA + ro); }
            { const int rbl = lane & 3, cql = lane >> 2;
#pragma unroll
              for (int p = 0; p < 2; ++p) { const int ps = 2 * wid + p, rbg = ps >> 2, cg = ps & 3; LAS unsigned char* vp = lds + VT + (4 * (16 * cg + cql)) * TS + (4 * (4 * rbg + rbl)) * 2;
                  u32x2 w;
                  w.x = (pv[p][0].x & 0xffffu) | (pv[p][1].x << 16); w.y = (pv[p][2].x & 0xffffu) | (pv[p][3].x << 16); *(LAS u32x2*)(vp) = w;
                  w.x = (pv[p][0].x >> 16) | (pv[p][1].x & 0xffff0000u); w.y = (pv[p][2].x >> 16) | (pv[p][3].x & 0xffff0000u); *(LAS u32x2*)(vp + TS) = w;
                  w.x = (pv[p][0].y & 0xffffu) | (pv[p][1].y << 16); w.y = (pv[p][2].y & 0xffffu) | (pv[p][3].y << 16); *(LAS u32x2*)(vp + 2 * TS) = w;
                  w.x = (pv[p][0].y >> 16) | (pv[p][1].y & 0xffff0000u); w.y = (pv[p][2].y >> 16) | (pv[p][3].y & 0xffff0000u); *(LAS u32x2*)(vp + 3 * TS) = w; } }
            GLA_LOADS(cnx);
            float x[4][4];
#pragma unroll
            for (int t = 0; t < 4; ++t) { u32x4 av = *(const LAS u32x4*)(lds + AW + (4 * rb + t) * 32 + (fq & 1) * 16); if (fq >= 2) av = (u32x4){0u, 0u, 0u, 0u};
                const f32x4 xa = mfma16(WgA, as_bf16x8(av), bgv);
                x[t][0] = xa[0]; x[t][1] = xa[1]; x[t][2] = xa[2]; x[t][3] = xa[3]; }
            float tot[4], inc[4];
#pragma unroll
            for (int cc = 0; cc < 4; ++cc) { float run = 0.f;
#pragma unroll
                for (int r = 0; r < 4; ++r) { const float xv = x[r][cc]; run += (fminf(xv, 0.f) * 1.4426950408889634f - __builtin_amdgcn_logf(1.0f + __builtin_amdgcn_exp2f(-1.4426950408889634f * fabsf(xv)))) * 0.0625f; x[r][cc] = run; }
                tot[cc] = run; inc[cc] = run; }
#pragma unroll
            for (int cc = 0; cc < 4; ++cc) { inc[cc] += dpp_f32<0x111>(inc[cc]); inc[cc] += dpp_f32<0x112>(inc[cc]); inc[cc] += dpp_f32<0x114>(inc[cc]); inc[cc] += dpp_f32<0x118>(inc[cc]); }
            float blast[4], ref[4];
#pragma unroll
            for (int cc = 0; cc < 4; ++cc) { const float ex = inc[cc] - tot[cc];
#pragma unroll
                for (int r = 0; r < 4; ++r) x[r][cc] += ex;
                blast[cc] = __shfl(inc[cc], (lane & 48) | 15); ref[cc] = __shfl(x[0][cc], (lane & 48) | 8); }
            { float kx[4][4], eref[4], elr[4];
#pragma unroll
              for (int cc = 0; cc < 4; ++cc) { eref[cc] = __builtin_amdgcn_exp2f(ref[cc]); elr[cc] = __builtin_amdgcn_exp2f(blast[cc] - ref[cc]); }
#pragma unroll
              for (int r = 0; r < 4; ++r) { const float q4[4] = {bflo(pq[r].x) * sc, bfhi(pq[r].x) * sc, bflo(pq[r].y) * sc, bfhi(pq[r].y) * sc}; const float k4[4] = {bflo(pk[r].x), bfhi(pk[r].x), bflo(pk[r].y), bfhi(pk[r].y)};
                  float qa[4], ka[4], qx[4];
#pragma unroll
                  for (int cc = 0; cc < 4; ++cc) { const float e1 = __builtin_amdgcn_exp2f(x[r][cc] - ref[cc]), e2 = __builtin_amdgcn_rcpf(e1); qa[cc] = q4[cc] * e1; ka[cc] = k4[cc] * e2; qx[cc] = qa[cc] * eref[cc]; kx[r][cc] = ka[cc] * elr[cc]; }
                  const int ro = (4 * rb + r) * RS + (16 * wid + 4 * cs) * 2;
                  u32x2 w; w.x = cvt_pk_bf16(qa[0], qa[1]); w.y = cvt_pk_bf16(qa[2], qa[3]); *(LAS u32x2*)(lds + QA + ro) = w;
                  w.x = cvt_pk_bf16(ka[0], ka[1]); w.y = cvt_pk_bf16(ka[2], ka[3]); *(LAS u32x2*)(lds + KA + ro) = w;
                  w.x = cvt_pk_bf16(qx[0], qx[1]); w.y = cvt_pk_bf16(qx[2], qx[3]); *(LAS u32x2*)(lds + QX + ro) = w; }
#pragma unroll
              for (int cc = 0; cc < 4; ++cc) { u32x2 w; w.x = cvt_pk_bf16(kx[0][cc], kx[1][cc]); w.y = cvt_pk_bf16(kx[2][cc], kx[3][cc]);
                  *(LAS u32x2*)(lds + KXT + (16 * wid + 4 * cs + cc) * TS + (4 * rb) * 2) = w; }
              if (rb == 0) *(LAS f32x4*)(lds + DEC + (16 * wid + 4 * cs) * 4) = (f32x4){__builtin_amdgcn_exp2f(blast[0]), __builtin_amdgcn_exp2f(blast[1]), __builtin_amdgcn_exp2f(blast[2]), __builtin_amdgcn_exp2f(blast[3])}; }
            __syncthreads();
            u32x2 ov[4][2];
            if (ph2) {
#pragma unroll
                for (int fi = 0; fi < 4; ++fi) { const size_t tk = TOKC(c, 16 * fi + fr);
#pragma unroll
                    for (int vf = 0; vf < 2; ++vf) ov[fi][vf] = *(const u32x2*)(other + tk * 1024 + hd * 256 + 32 * wid + 4 * fq + 16 * vf); } }
            { const int fi = wid >> 1, fj0 = 2 * (wid & 1); f32x4 a0 = (f32x4){0.f, 0.f, 0.f, 0.f}, a1 = (f32x4){0.f, 0.f, 0.f, 0.f};
#pragma unroll
              for (int ks = 0; ks < 4; ++ks) { const bf16x8 qf_ = *(const LAS bf16x8*)(lds + QA + (16 * fi + fr) * RS + ks * 64 + fq * 16);
                  if (fj0 <= fi) a0 = mfma16(qf_, *(const LAS bf16x8*)(lds + KA + (16 * fj0 + fr) * RS + ks * 64 + fq * 16), a0);
                  if (fj0 + 1 <= fi) a1 = mfma16(qf_, *(const LAS bf16x8*)(lds + KA + (16 * (fj0 + 1) + fr) * RS + ks * 64 + fq * 16), a1); }
#pragma unroll
              for (int e = 0; e < 4; ++e) { const int i = 16 * fi + 4 * fq + e, j0 = 16 * fj0 + fr, j1 = j0 + 16; const bool k0 = dir ? (j0 < i) : (j0 <= i), k1 = dir ? (j1 < i) : (j1 <= i);
                  *(LAS unsigned short*)(lds + ATT + i * TS + j0 * 2) = f2bf1(k0 ? a0[e] : 0.f); *(LAS unsigned short*)(lds + ATT + i * TS + j1 * 2) = f2bf1(k1 ? a1[e] : 0.f); } }
            bf16x8 vb[2][2];
#pragma unroll
            for (int vf = 0; vf < 2; ++vf)
#pragma unroll
                for (int ks = 0; ks < 2; ++ks) vb[vf][ks] = *(const LAS bf16x8*)(lds + VT + (32 * wid + 16 * vf + fr) * TS + ks * 64 + fq * 16);
            f32x4 o[4][2];
#pragma unroll
            for (int fi = 0; fi < 4; ++fi) { o[fi][0] = (f32x4){0.f, 0.f, 0.f, 0.f}; o[fi][1] = (f32x4){0.f, 0.f, 0.f, 0.f}; }
#pragma unroll
            for (int a4 = 0; a4 < 4; ++a4) { bf16x8 sb[2];
#pragma unroll
                for (int vf = 0; vf < 2; ++vf) { u32x4 p; p.x = cvt_pk_bf16(S[2 * a4][vf][0], S[2 * a4][vf][1]); p.y = cvt_pk_bf16(S[2 * a4][vf][2], S[2 * a4][vf][3]); p.z = cvt_pk_bf16(S[2 * a4 + 1][vf][0], S[2 * a4 + 1][vf][1]); p.w = cvt_pk_bf16(S[2 * a4 + 1][vf][2], S[2 * a4 + 1][vf][3]); sb[vf] = as_bf16x8(p); }
#pragma unroll
                for (int fi = 0; fi < 4; ++fi) { const LAS unsigned char* qp = lds + QX + (16 * fi + fr) * RS + (32 * a4 + 4 * fq) * 2; const u32x2 lo = *(const LAS u32x2*)qp, hi = *(const LAS u32x2*)(qp + 32);
                    u32x4 qa; qa.x = lo.x; qa.y = lo.y; qa.z = hi.x; qa.w = hi.y; const bf16x8 Bq = as_bf16x8(qa); o[fi][0] = mfma16(sb[0], Bq, o[fi][0]); o[fi][1] = mfma16(sb[1], Bq, o[fi][1]); } }
#pragma unroll
            for (int kf = 0; kf < 8; ++kf) { const f32x4 d4 = *(const LAS f32x4*)((const LAS float*)(lds + DEC) + 16 * kf + 4 * fq); S[kf][0] *= d4; S[kf][1] *= d4; }
#pragma unroll
            for (int ks = 0; ks < 2; ++ks)
#pragma unroll
                for (int kf = 0; kf < 8; ++kf) { const bf16x8 a = *(const LAS bf16x8*)(lds + KXT + (16 * kf + fr) * TS + ks * 64 + fq * 16); S[kf][0] = mfma16(a, vb[0][ks], S[kf][0]); S[kf][1] = mfma16(a, vb[1][ks], S[kf][1]); }
            GLA_STAGE_A();
            __syncthreads();
#pragma unroll
            for (int ks = 0; ks < 2; ++ks)
#pragma unroll
                for (int fi = 0; fi < 4; ++fi) { const bf16x8 a = *(const LAS bf16x8*)(lds + ATT + (16 * fi + fr) * TS + ks * 64 + fq * 16); o[fi][0] = mfma16(vb[0][ks], a, o[fi][0]); o[fi][1] = mfma16(vb[1][ks], a, o[fi][1]); }
            u32x2 zv[4][2];
            if (!ph2) {
#pragma unroll
                for (int fi = 0; fi < 4; ++fi) { bf16_t* op = obuf + TOKC(c, 16 * fi + fr) * 1024 + hd * 256 + 32 * wid + 4 * fq;
#pragma unroll
                    for (int vf = 0; vf < 2; ++vf) { u32x2 w; w.x = cvt_pk_bf16(o[fi][vf][0], o[fi][vf][1]); w.y = cvt_pk_bf16(o[fi][vf][2], o[fi][vf][3]); *(u32x2*)(op + 16 * vf) = w; } }
            } else {
#pragma unroll
                for (int fi = 0; fi < 4; ++fi) { const size_t tk = TOKC(c, 16 * fi + fr);
#pragma unroll
                    for (int vf = 0; vf < 2; ++vf) zv[fi][vf] = *(const u32x2*)(proj + tk * ODD_IN + 2048 + hd * 256 + 32 * wid + 4 * fq + 16 * vf); }
#pragma unroll
                for (int fi = 0; fi < 4; ++fi) { float ss = 0.f;
#pragma unroll
                    for (int vf = 0; vf < 2; ++vf) { o[fi][vf][0] += bflo(ov[fi][vf].x); o[fi][vf][1] += bfhi(ov[fi][vf].x); o[fi][vf][2] += bflo(ov[fi][vf].y); o[fi][vf][3] += bfhi(ov[fi][vf].y);
                        ss += (o[fi][vf][0] * o[fi][vf][0] + o[fi][vf][1] * o[fi][vf][1]) + (o[fi][vf][2] * o[fi][vf][2] + o[fi][vf][3] * o[fi][vf][3]); }
                    ss += __shfl_xor(ss, 16); ss += __shfl_xor(ss, 32);
                    if (fq == 0) ((LAS float*)(lds + PART))[wid * 64 + 16 * fi + fr] = ss; }
            }
            GLA_STAGE_QK();
            __syncthreads();
            if (ph2) {
                const f32x4 gw0 = *(const f32x4*)(gw + 32 * wid + 4 * fq), gw1 = *(const f32x4*)(gw + 32 * wid + 16 + 4 * fq);
#pragma unroll
                for (int fi = 0; fi < 4; ++fi) { float tot = 0.f;
#pragma unroll
                    for (int w = 0; w < 8; ++w) tot += ((const LAS float*)(lds + PART))[w * 64 + 16 * fi + fr];
                    const float r = __builtin_amdgcn_rsqf(tot * (1.f / 256.f) + 1e-6f);
                    bf16_t* mp = mix + TOKC(c, 16 * fi + fr) * 1024 + hd * 256 + 32 * wid + 4 * fq;
#pragma unroll
                    for (int vf = 0; vf < 2; ++vf) { const f32x4 gv = vf ? gw1 : gw0; const u32x2 z = zv[fi][vf];
                        u32x2 w; w.x = cvt_pk_bf16(o[fi][vf][0] * r * gv[0] * siluf(bflo(z.x)), o[fi][vf][1] * r * gv[1] * siluf(bfhi(z.x))); w.y = cvt_pk_bf16(o[fi][vf][2] * r * gv[2] * siluf(bflo(z.y)), o[fi][vf][3] * r * gv[3] * siluf(bfhi(z.y)));
                        *(u32x2*)(mp + 16 * vf) = w; } }
                        }
        }
        if (!ph2) {
#pragma unroll
            for (int kf = 0; kf < 8; ++kf)
#pragma unroll
                for (int vf = 0; vf < 2; ++vf) *(f32x4*)(sst + ((kf * 2 + vf) * 64 + X.lane) * 4) = S[kf][vf]; }
#undef CHUNK
#undef GLA_STAGE_A
#undef GLA_STAGE_QK
#undef GLA_LOADS
#undef TOKC
    }
}
__device__ __forceinline__ void gla_finish_phase(const Ctx& X, const bf16_t* OF, const bf16_t* OB, const bf16_t* proj, const float* gw, bf16_t* mix) {
    const int gwv = X.vcu * 8 + X.wid, NGW = X.G * 8, col0 = X.lane * 16;
    f32x4 w4[4];
#pragma unroll
    for (int q = 0; q < 4; ++q) w4[q] = *(const f32x4*)(gw + (col0 & 255) + 4 * q);
#pragma unroll 2
    for (int m = gwv; m < MTOK; m += NGW) {
        const u32x4* pf = (const u32x4*)(OF + (size_t)m * 1024 + col0); const u32x4* pb = (const u32x4*)(OB + (size_t)m * 1024 + col0); const u32x4* pz = (const u32x4*)(proj + (size_t)m * ODD_IN + 2048 + col0);
        float v[16], z[16]; float ss = 0.f;
#pragma unroll
        for (int h = 0; h < 2; ++h) { const u32x4 a = pf[h], c = pb[h], zz = pz[h];
            v[8 * h + 0] = bflo(a.x) + bflo(c.x); v[8 * h + 1] = bfhi(a.x) + bfhi(c.x); v[8 * h + 2] = bflo(a.y) + bflo(c.y); v[8 * h + 3] = bfhi(a.y) + bfhi(c.y);
            v[8 * h + 4] = bflo(a.z) + bflo(c.z); v[8 * h + 5] = bfhi(a.z) + bfhi(c.z); v[8 * h + 6] = bflo(a.w) + bflo(c.w); v[8 * h + 7] = bfhi(a.w) + bfhi(c.w);
            z[8 * h + 0] = bflo(zz.x); z[8 * h + 1] = bfhi(zz.x); z[8 * h + 2] = bflo(zz.y); z[8 * h + 3] = bfhi(zz.y); z[8 * h + 4] = bflo(zz.z); z[8 * h + 5] = bfhi(zz.z); z[8 * h + 6] = bflo(zz.w); z[8 * h + 7] = bfhi(zz.w); }
#pragma unroll
        for (int e = 0; e < 16; ++e) ss += v[e] * v[e];
        ss += __shfl_xor(ss, 1); ss += __shfl_xor(ss, 2); ss += __shfl_xor(ss, 4); ss += __shfl_xor(ss, 8);
        const float r = 1.0f / sqrtf(ss * (1.f / 256.f) + 1e-6f);
        float y[16];
#pragma unroll
        for (int e = 0; e < 16; ++e) y[e] = v[e] * r * w4[e >> 2][e & 3] * siluf(z[e]);
        u32x4 o0, o1; o0.x = cvt_pk_bf16(y[0], y[1]); o0.y = cvt_pk_bf16(y[2], y[3]); o0.z = cvt_pk_bf16(y[4], y[5]); o0.w = cvt_pk_bf16(y[6], y[7]);
        o1.x = cvt_pk_bf16(y[8], y[9]); o1.y = cvt_pk_bf16(y[10], y[11]); o1.z = cvt_pk_bf16(y[12], y[13]); o1.w = cvt_pk_bf16(y[14], y[15]);
        u32x4* po = (u32x4*)(mix + (size_t)m * 1024 + col0); po[0] = o0; po[1] = o1;
    }
}

struct Args { const float* in[17]; float* out; unsigned char* ws; int ph_lo, ph_hi; };
constexpr int N_PHASES = 2 + 6 * DEPTH;
__global__ void __launch_bounds__(512, 2) fwd_mega(Args args) {
    extern __shared__ __attribute__((aligned(16))) unsigned char lds_raw[];
    LAS unsigned char* lds = (LAS unsigned char*)lds_raw;
    cg::grid_group grid = cg::this_grid();
    Ctx X; X.tid = threadIdx.x; X.lane = X.tid & 63; X.wid = __builtin_amdgcn_readfirstlane(X.tid >> 6); X.G = gridDim.x;
    { const int bx = blockIdx.x; X.vcu = (X.G % 8 == 0) ? (bx % 8) * (X.G / 8) + bx / 8 : bx; }
    const float* x_in = args.in[0]; const float* c_in = args.in[1]; const float* norm_w = args.in[2]; const float* w_ada = args.in[3]; const float* b_ada = args.in[4];
    const float* pool_scale = args.in[7]; const float* q_norm_w = args.in[8]; const float* k_norm_w = args.in[9]; const float* attn_sink = args.in[10];
    const float* w_gate_up = args.in[13]; const float* b_gate = args.in[14]; const float* gla_norm_w = args.in[15];
    unsigned char* ws = args.ws; float* out = args.out;
    float* mod = (float*)(ws + WS_MOD); bf16_t* H = (bf16_t*)(ws + WS_H); bf16_t* PROJ = (bf16_t*)(ws + WS_PROJ); bf16_t* VTg = (bf16_t*)(ws + WS_VT); bf16_t* OF = (bf16_t*)(ws + WS_OF); bf16_t* OB = (bf16_t*)(ws + WS_OB);
    bf16_t* HP = (bf16_t*)(ws + WS_HP); float* ROWSS = (float*)(ws + WS_ROWSS); float* SHW = (float*)(ws + WS_SHW);
    const int lo = args.ph_lo, hi = args.ph_hi;
    if (threadIdx.x < 16) ((LAS unsigned*)(lds + LDS_MISC))[threadIdx.x] = 0u;
    __syncthreads();
    XcdBarrier bar = xcd_barrier_post((unsigned*)(ws + WS_BAR), (volatile LAS unsigned*)(lds + LDS_MISC));
    const bool one = (hi - lo) > 1;
#define IN(k) (lo <= (k) && (k) < hi)
#define FRESH(Y) Ctx Y = X; asm volatile("" : "+v"(Y.tid), "+v"(Y.lane))
#define SEAM(k) do { if (one && IN((k) + 1)) xcd_barrier(bar); } while (0)
    if (hi < 0) grid.sync();
    if (IN(0)) { FRESH(Y); mod_phase(lds, Y, c_in, w_ada, b_ada, mod); SEAM(0); }
    if (IN(1)) { WPtrs P{args.in[5], args.in[11], args.in[12], args.in[16], args.in[6]}; FRESH(Y); shiftw_phase(lds, Y, mod, args.in[5], args.in[12], SHW); transpose_phase(lds, Y, P, ws); __syncthreads();
        prenorm_phase(Y, x_in, norm_w, mod, HP, ROWSS); SEAM(1); }
#pragma unroll 1
    for (int l = 0; l < DEPTH; ++l) {
        const int pb = 2 + 6 * l, i2 = l >> 1; const bool odd = (l & 1) != 0;
        const float* xsrc = (l == 0) ? x_in : out; const float* modl = mod + (size_t)l * 32 * 3072;
        if (IN(pb + 1)) {
            const bf16_t* Ap = HP; const bf16_t* Bp = (const bf16_t*)(ws + (odd ? WS_WINC : WS_WINA)) + (size_t)i2 * (odd ? ODD_INP : EVEN_IN) * 1024; asm volatile("" : "+s"(Ap), "+s"(Bp));
            if (!odd) { pg8::Gemm g{Ap, Bp, MTOK, EVEN_IN, D}; pg8::StaticOrder S; S.init(MTOK, EVEN_IN, X.G, (int)blockIdx.x);
                pg8::EpiProj E{PROJ, EVEN_IN, EVEN_IN, VTg, ROWSS + (size_t)l * MTOK, SHW + (size_t)l * 32 * 3328}; pg8::gemm_phase<pg8::EpiProj, pg8::StaticOrder, GEMM_ALIGN, GEMM_SP2>(lds, g, S, E); }
            else { pg8::Gemm g{Ap, Bp, MTOK, ODD_INP, D}; pg8::StaticOrder S; S.init(MTOK, ODD_INP, X.G, (int)blockIdx.x);
                pg8::EpiProj E{PROJ, ODD_IN, ODD_IN, nullptr, ROWSS + (size_t)l * MTOK, SHW + (size_t)l * 32 * 3328}; pg8::gemm_phase<pg8::EpiProj, pg8::StaticOrder, GEMM_ALIGN, GEMM_SP2>(lds, g, S, E); }
            SEAM(pb + 1);
        }
        if (IN(pb + 2)) {
#ifdef DUP_MIX
            for (int rep = 0; rep < 2; ++rep) {
#endif
            FRESH(Y); if (!odd) { pool_phase(lds, Y, PROJ, (const bf16_t*)(ws + WS_WPT) + (size_t)i2 * 4 * 16384, pool_scale + i2 * 512, H);
                attn_phase(lds, Y, PROJ, VTg, q_norm_w + i2 * 64, k_norm_w + i2 * 64, attn_sink + i2 * 8, H); }
            else gla_phase(lds, Y, PROJ, w_gate_up + (size_t)i2 * 2 * 16 * 512, b_gate + i2 * 2 * 512, OF, OB, (float*)(ws + WS_SST), false, gla_norm_w + i2 * 256, H);
#ifdef DUP_MIX
            }
#endif
            SEAM(pb + 2);
        }
        if (IN(pb + 3)) { FRESH(Y); if (odd) gla_phase(lds, Y, PROJ, w_gate_up + (size_t)i2 * 2 * 16 * 512, b_gate + i2 * 2 * 512, OF, OB, (float*)(ws + WS_SST), true, gla_norm_w + i2 * 256, H); if (odd) SEAM(pb + 3); }
        if (IN(pb + 4)) {
            const bf16_t* Ap = H; const bf16_t* Bp = (const bf16_t*)(ws + (odd ? WS_WOUTC : WS_WOUTA)) + (size_t)i2 * 1024 * 1024; asm volatile("" : "+s"(Ap), "+s"(Bp));
            pg8::Gemm g{Ap, Bp, MTOK, D, D}; pg8::StaticOrder S; S.init(MTOK, D, X.G, (int)blockIdx.x);
            pg8::EpiOut E{xsrc, out, modl + 2048, (l + 1 < DEPTH) ? HP : nullptr, norm_w + (l + 1) * 1024, modl + 32 * 3072 + 1024, ROWSS + (size_t)(l + 1) * MTOK}; pg8::gemm_phase<pg8::EpiOut, pg8::StaticOrder, GEMM_ALIGN, GEMM_SP2>(lds, g, S, E);
            if (l + 1 < DEPTH) { if (one && IN(pb + 6)) xcd_barrier(bar); }
        }
    }
#undef IN
#undef SEAM
}

#ifndef MK_ONE_LAUNCH
#define MK_ONE_LAUNCH 1
#endif
extern "C" void kernel_launch(void* const* d_in, const int* in_sizes, int n_in, void* d_out, int out_size, void* d_ws, size_t ws_size, hipStream_t stream) {
    static int grid = 0;
    if (grid == 0) {
        int dev = 0, cus = 0, per_cu = 0;
        if (hipGetDevice(&dev) != hipSuccess || hipDeviceGetAttribute(&cus, hipDeviceAttributeMultiprocessorCount, dev) != hipSuccess) { fprintf(stderr, "kernel_launch: device query failed\n"); grid = -1; return; }
        if (hipFuncSetAttribute((const void*)fwd_mega, hipFuncAttributeMaxDynamicSharedMemorySize, LDS_BYTES) != hipSuccess) { fprintf(stderr, "kernel_launch: hipFuncSetAttribute failed\n"); grid = -1; return; }
        if (hipOccupancyMaxActiveBlocksPerMultiprocessor(&per_cu, (const void*)fwd_mega, 512, LDS_BYTES) != hipSuccess || per_cu < 1) fprintf(stderr, "kernel_launch: occupancy query reports %d\n", per_cu);
        (void)hipGetLastError();
        if (n_in != 17 || out_size != MTOK * D || ws_size < WS_END) { fprintf(stderr, "kernel_launch: unexpected shapes (n_in %d out %d ws %zu)\n", n_in, out_size, ws_size); grid = -1; return; }
        grid = cus;
    }
    if (grid < 0) return;
    if (hipMemsetAsync((unsigned char*)d_ws + WS_BAR, 0, 16384, stream) != hipSuccess) fprintf(stderr, "kernel_launch: memset failed\n");
    if (hipMemsetAsync((unsigned char*)d_ws + WS_ROWSS, 0, 4 * MTOK * sizeof(float), stream) != hipSuccess) fprintf(stderr, "kernel_launch: memset failed\n");
    Args a{};
    for (int i = 0; i < 17; ++i) a.in[i] = (const float*)d_in[i];
    a.out = (float*)d_out; a.ws = (unsigned char*)d_ws;
#if MK_ONE_LAUNCH
    a.ph_lo = 0; a.ph_hi = N_PHASES;
    void* kargs[] = {&a};
    hipError_t e = hipLaunchCooperativeKernel((void*)fwd_mega, dim3(grid), dim3(512), kargs, LDS_BYTES, stream);
    if (e != hipSuccess) fprintf(stderr, "kernel_launch: cooperative launch failed: %s (grid %d)\n", hipGetErrorString(e), grid);
#else
    for (int p = 0; p < N_PHASES; ++p) { const int q = (p - 2) % 6; if (p >= 2 && (q == 5 || q == 0 || (q == 3 && (((p - 2) / 6) & 1) == 0))) continue;
        a.ph_lo = p; a.ph_hi = p + 1; void* kargs[] = {&a};
        hipError_t e = hipLaunchCooperativeKernel((void*)fwd_mega, dim3(grid), dim3(512), kargs, LDS_BYTES, stream);
        if (e != hipSuccess) { fprintf(stderr, "kernel_launch: launch of phase %d failed: %s\n", p, hipGetErrorString(e)); break; } }
#endif
}
```

```cpp
#include <hip/hip_runtime.h>
#include <hip/hip_cooperative_groups.h>
#include <cstdio>
namespace cg = cooperative_groups;

namespace pg8 {
#define PG8_LAS __attribute__((address_space(3)))
typedef unsigned short bf16_t;
typedef short bf16x8 __attribute__((ext_vector_type(8)));
typedef float f32x4 __attribute__((ext_vector_type(4)));
typedef unsigned u32x4 __attribute__((ext_vector_type(4)));
typedef unsigned u32x2 __attribute__((ext_vector_type(2)));
constexpr int BM = 256, BK = 64, HALF = 128, HTB = HALF * BK * 2  , STAGE_BYTES = 8 * HTB, NXCD = 8, WGM = 8;

__host__ __device__ __forceinline__ int lds_byte(int r, int c) { const int st = (r >> 4) * 2 + (c >> 5), rr = r & 15, cc = c & 31, ob = rr * 64 + cc * 2; return st * 1024 + (ob ^ (((ob >> 9) & 1) << 5)); }
__host__ __device__ __forceinline__ void stage_rc(int b, int& R, int& C) { const int st = b / 1024, sb = b % 1024, swz = sb ^ (((sb >> 9) & 1) << 5); R = (st >> 1) * 16 + swz / 64; C = (st & 1) * 32 + (swz % 64) / 2; }
__host__ __device__ __forceinline__ int perm32(int rho) { const int n = rho >> 4, i = rho & 15; return 8 * (i >> 2) + 4 * n + (i & 3); }

struct Unit { int pm, pn; };
struct Gemm { const bf16_t* A; const bf16_t* Bt; int M, N, K; };

struct StaticOrder {
    int nM, nN, nwg, G, c;
    __host__ __device__ void init(int M, int N, int G_, int c_) { nM = M / BM; nN = N / BM; nwg = nM * nN; G = G_; c = c_; }
    __host__ __device__ bool next(int i, Unit& u) const {
        const long L = (long)i * G + c; if (L >= nwg) return false;
        int wgid = (int)L; { const int q = nwg / NXCD, r = nwg % NXCD, xcd = wgid % NXCD, off = wgid / NXCD; wgid = (xcd < r ? xcd * (q + 1) : r * (q + 1) + (xcd - r) * q) + off; }
        const int nig = WGM * nN, gid = wgid / nig, fm = gid * WGM, gsz = (nM - fm) < WGM ? (nM - fm) : WGM;
        u.pm = fm + ((wgid % nig) % gsz); u.pn = (wgid % nig) / gsz; return true;
    }
    __device__ __forceinline__ void a_ready(const Unit&) const {}
    __device__ __forceinline__ void done(const Unit&) const {}
};

typedef __bf16 bf16v2_t __attribute__((ext_vector_type(2)));
typedef float f32v2_t __attribute__((ext_vector_type(2)));
__device__ __forceinline__ unsigned cvt_pk_bf16(float lo, float hi) { const f32v2_t v = {lo, hi}; const bf16v2_t b = __builtin_convertvector(v, bf16v2_t); return __builtin_bit_cast(unsigned, b); }
__device__ __forceinline__ unsigned short f2bf1(float f) { return (unsigned short)(cvt_pk_bf16(f, 0.f) & 0xffffu); }

struct EpiProj {
    static constexpr bool PERM = true, AFTER_DRAIN = false;
    bf16_t* O; int ldc; int ncols; bf16_t* VT; const float* rowss; const float* shw;
    __device__ __forceinline__ void operator()(const f32x4 (&acc)[2][2][4][2], const Unit& u, int wr, int wc, int fr, int fq) const {
        const int row0 = u.pm * BM + wr * 64 + fr, col0 = u.pn * BM + wc * 32 + 8 * fq;
        const bool dov = (VT != nullptr) && (u.pn == 6);
        const int vc = wc * 32 + 8 * fq, b = (u.pm * BM) >> 11;
        bf16_t* vbase = VT + ((size_t)((b * 2 + (vc >> 6)) * 64 + (vc & 63))) * 2048 + (row0 & 2047);
        f32x4 sh[2][2];
#pragma unroll
        for (int bj = 0; bj < 2; ++bj) { sh[bj][0] = *(const f32x4*)(shw + b * 3328 + col0 + bj * HALF); sh[bj][1] = *(const f32x4*)(shw + b * 3328 + col0 + bj * HALF + 4); }
        float rs[2][4];
#pragma unroll
        for (int ai = 0; ai < 2; ++ai)
#pragma unroll
            for (int m = 0; m < 4; ++m) rs[ai][m] = rowss[row0 + ai * HALF + m * 16];
#pragma unroll
        for (int ai = 0; ai < 2; ++ai)
#pragma unroll
            for (int m = 0; m < 4; ++m) { const int row = row0 + ai * HALF + m * 16; bf16_t* rowp = O + (size_t)row * ldc + col0;
                const float r = __builtin_amdgcn_rsqf(rs[ai][m] * (1.0f / 1024.0f) + 1e-6f);
#pragma unroll
                for (int bj = 0; bj < 2; ++bj) { const f32x4 v0 = acc[ai][bj][m][0] * r + sh[bj][0], v1 = acc[ai][bj][m][1] * r + sh[bj][1];
                    u32x4 w; w.x = cvt_pk_bf16(v0[0], v0[1]); w.y = cvt_pk_bf16(v0[2], v0[3]); w.z = cvt_pk_bf16(v1[0], v1[1]); w.w = cvt_pk_bf16(v1[2], v1[3]);
                    if (col0 + bj * HALF < ncols) *(u32x4*)(rowp + bj * HALF) = w;
                    if (bj == 1 && dov) { bf16_t* vp = vbase + ai * HALF + m * 16;
                        vp[0 * 2048] = (bf16_t)(w.x & 0xffffu); vp[1 * 2048] = (bf16_t)(w.x >> 16); vp[2 * 2048] = (bf16_t)(w.y & 0xffffu); vp[3 * 2048] = (bf16_t)(w.y >> 16);
                        vp[4 * 2048] = (bf16_t)(w.z & 0xffffu); vp[5 * 2048] = (bf16_t)(w.z >> 16); vp[6 * 2048] = (bf16_t)(w.w & 0xffffu); vp[7 * 2048] = (bf16_t)(w.w >> 16); } }
                asm volatile("" ::: "memory"); }
    }
};
struct EpiOut {
    static constexpr bool PERM = false, AFTER_DRAIN = false;
    const float* xin; float* xout; const float* gate;
    bf16_t* hp; const float* nwn; const float* scn; float* rssn;
    __device__ __forceinline__ void operator()(const f32x4 (&acc)[2][2][4][2], const Unit& u, int wr, int wc, int fr, int fq) const {
        const int row0 = u.pm * BM + wr * 64 + fr, col0 = u.pn * BM + wc * 32 + 4 * fq, b = (u.pm * BM) >> 11;
        const bool nx = hp != nullptr;
        f32x4 g[2][2], ws[2][2];
#pragma unroll
        for (int bj = 0; bj < 2; ++bj)
#pragma unroll
            for (int n = 0; n < 2; ++n) { const int c = col0 + bj * HALF + n * 16; g[bj][n] = *(const f32x4*)(gate + b * 3072 + c);
                ws[bj][n] = nx ? *(const f32x4*)(nwn + c) * (*(const f32x4*)(scn + b * 3072 + c) + 1.0f) : (f32x4){0.f, 0.f, 0.f, 0.f}; }
#pragma unroll
        for (int ai = 0; ai < 2; ++ai)
#pragma unroll
            for (int m = 0; m < 4; ++m) { const int row = row0 + ai * HALF + m * 16; const size_t off = (size_t)row * 1024 + col0; float ss = 0.f;
#pragma unroll
                for (int bj = 0; bj < 2; ++bj)
#pragma unroll
                    for (int n = 0; n < 2; ++n) { const f32x4 xo = *(const f32x4*)(xin + off + bj * HALF + n * 16); const f32x4 xn = xo + g[bj][n] * acc[ai][bj][m][n];
                        *(f32x4*)(xout + off + bj * HALF + n * 16) = xn;
                        if (nx) { ss += (xn[0] * xn[0] + xn[1] * xn[1]) + (xn[2] * xn[2] + xn[3] * xn[3]); const f32x4 h = xn * ws[bj][n];
                            u32x2 w; w.x = cvt_pk_bf16(h[0], h[1]); w.y = cvt_pk_bf16(h[2], h[3]); *(u32x2*)(hp + off + bj * HALF + n * 16) = w; } }
                if (nx) { ss += __shfl_xor(ss, 16); ss += __shfl_xor(ss, 32); if (fq == 0) atomicAdd(rssn + row, ss); }
                asm volatile("" ::: "memory"); }
    }
};

template <class Epi, class Sched, bool ALIGN_EPI = false, bool SP2 = false>
__device__ __forceinline__ void gemm_phase(PG8_LAS unsigned char* lds, const Gemm g, const Sched& S, const Epi& E) {
    int tid_ = threadIdx.x; asm volatile("" : "+v"(tid_));
    const int tid = tid_, wid = __builtin_amdgcn_readfirstlane(tid >> 6), lane = tid & 63, wr = wid >> 2, wc = wid & 3, fr = lane & 15, fq = lane >> 4;
    const int K = g.K, nt = K / BK;
    unsigned voffA[2], voffB[2];
#pragma unroll
    for (int i = 0; i < 2; ++i) { int R, C; stage_rc(tid * 16 + i * 8192, R, C); const int Rb = Epi::PERM ? ((R & ~31) + perm32(R & 31)) : R;
        voffA[i] = (unsigned)(R * K + C) * 2u; voffB[i] = (unsigned)(Rb * K + C) * 2u; }
    const size_t kstep = (size_t)(BK * 2);
    const size_t hstep = (size_t)HALF * K * 2;
    const size_t tstep = 2 * hstep;
    const unsigned ldsw = (unsigned)wid * 1024u;
    const int aoff = lds_byte(wr * 64 + fr, fq * 8), boff = lds_byte(wc * 32 + fr, fq * 8);
#define PG8_SA(b, h) (((b) * 2 + (h)) * HTB)
#define PG8_SB(b, h) ((4 + (b) * 2 + (h)) * HTB)
#define PG8_STAGE(bufoff, gbase, voff) do { _Pragma("unroll") for (int _i = 0; _i < 2; ++_i) \
        __builtin_amdgcn_global_load_lds((const unsigned*)((const char*)(gbase) + (voff)[_i]), (PG8_LAS unsigned*)(lds + (bufoff) + ldsw + _i * 8192), 16, 0, 0); } while (0)
#define PG8_LDA(dst, b, h) do { _Pragma("unroll") for (int m = 0; m < 4; ++m) _Pragma("unroll") for (int k = 0; k < 2; ++k) dst[m][k] = *(const PG8_LAS bf16x8*)(lds + PG8_SA(b, h) + aoff + m * 2048 + k * 1024); } while (0)
#define PG8_LDB(dst, b, h) do { _Pragma("unroll") for (int n = 0; n < 2; ++n) _Pragma("unroll") for (int k = 0; k < 2; ++k) dst[n][k] = *(const PG8_LAS bf16x8*)(lds + PG8_SB(b, h) + boff + n * 2048 + k * 1024); } while (0)
#define PG8_MMA(ai, bj, At, Bt) do { __builtin_amdgcn_s_setprio(1); _Pragma("unroll") for (int m = 0; m < 4; ++m) _Pragma("unroll") for (int n = 0; n < 2; ++n) _Pragma("unroll") for (int k = 0; k < 2; ++k) \
        acc[ai][bj][m][n] = __builtin_amdgcn_mfma_f32_16x16x32_bf16(Bt[n][k], At[m][k], acc[ai][bj][m][n], 0, 0, 0); __builtin_amdgcn_s_setprio(0); } while (0)
#define PG8_WAIT_V(n) asm volatile("s_waitcnt vmcnt(" #n ")" ::: "memory")
#define PG8_WAIT_L(n) asm volatile("s_waitcnt lgkmcnt(" #n ")" ::: "memory")
#define PG8_BAR __builtin_amdgcn_s_barrier()
#define PG8_SCHED __builtin_amdgcn_sched_barrier(0)
    Unit cur, nxt; int ui = 0;
    if (!S.next(0, cur)) return;
    f32x4 acc[2][2][4][2];
#pragma unroll
    for (int a = 0; a < 2; ++a)
#pragma unroll
        for (int b = 0; b < 2; ++b)
#pragma unroll
            for (int m = 0; m < 4; ++m)
#pragma unroll
                for (int n = 0; n < 2; ++n) acc[a][b][m][n] = (f32x4){0.f, 0.f, 0.f, 0.f};
    bf16x8 At[4][2], B0[2][2], B1[2][2];
    const char* cA = (const char*)g.A + (size_t)cur.pm * tstep; const char* cB = (const char*)g.Bt + (size_t)cur.pn * tstep;
    S.a_ready(cur);
    if constexpr (SP2) {
        PG8_STAGE(PG8_SB(0, 0), cB, voffB); PG8_STAGE(PG8_SB(0, 1), cB + hstep, voffB); PG8_STAGE(PG8_SA(0, 0), cA, voffA); PG8_STAGE(PG8_SA(0, 1), cA + hstep, voffA);
        if (wr == 1) PG8_BAR;
        PG8_WAIT_V(2); PG8_BAR;
        PG8_STAGE(PG8_SB(1, 0), cB + kstep, voffB); PG8_STAGE(PG8_SA(1, 0), cA + kstep, voffA); PG8_STAGE(PG8_SB(1, 1), cB + hstep + kstep, voffB);
        PG8_WAIT_V(6); PG8_BAR;
    } else {
        PG8_STAGE(PG8_SB(0, 0), cB, voffB); PG8_STAGE(PG8_SA(0, 0), cA, voffA); PG8_STAGE(PG8_SB(0, 1), cB + hstep, voffB); PG8_STAGE(PG8_SA(0, 1), cA + hstep, voffA);
        if (wr == 1) PG8_BAR;
        PG8_WAIT_V(4); PG8_BAR;
        PG8_STAGE(PG8_SB(1, 0), cB + kstep, voffB); PG8_STAGE(PG8_SA(1, 0), cA + kstep, voffA); PG8_STAGE(PG8_SB(1, 1), cB + hstep + kstep, voffB);
        PG8_WAIT_V(6); PG8_BAR;
    }
    for (;;) {
        const bool has_next = S.next(ui + 1, nxt);
        const char* nA = has_next ? (const char*)g.A + (size_t)nxt.pm * tstep : cA; const char* nB = has_next ? (const char*)g.Bt + (size_t)nxt.pn * tstep : cB;
        for (int t = 0; t < nt; t += 2) {
            const bool last = (t == nt - 2);
            const char* a1 = cA + (size_t)(t + 1) * kstep;
            const char* a2 = last ? nA : cA + (size_t)(t + 2) * kstep; const char* b2 = last ? nB : cB + (size_t)(t + 2) * kstep;
            const char* a3 = a2 + kstep; const char* b3 = b2 + kstep;
            if (last && has_next) S.a_ready(nxt);
            if constexpr (SP2) {
            PG8_LDB(B0, 0, 0); PG8_LDB(B1, 0, 1); PG8_SCHED; PG8_LDA(At, 0, 0); PG8_STAGE(PG8_SA(1, 1), a1 + hstep, voffA);
            PG8_WAIT_V(8); PG8_WAIT_L(0); PG8_BAR; PG8_MMA(0, 0, At, B0); PG8_MMA(0, 1, At, B1); PG8_BAR; PG8_SCHED;
            PG8_LDA(At, 0, 1); PG8_STAGE(PG8_SB(0, 0), b2, voffB); PG8_STAGE(PG8_SB(0, 1), b2 + hstep, voffB); PG8_STAGE(PG8_SA(0, 0), a2, voffA);
            PG8_WAIT_V(8); PG8_WAIT_L(0); PG8_BAR; PG8_MMA(1, 0, At, B0); PG8_MMA(1, 1, At, B1); PG8_BAR; PG8_SCHED;
            PG8_LDB(B0, 1, 0); PG8_LDB(B1, 1, 1); PG8_SCHED; PG8_LDA(At, 1, 0); PG8_STAGE(PG8_SA(0, 1), a2 + hstep, voffA);
            PG8_WAIT_V(8); PG8_WAIT_L(0); PG8_BAR; PG8_MMA(0, 0, At, B0); PG8_MMA(0, 1, At, B1); PG8_BAR; PG8_SCHED;
            PG8_LDA(At, 1, 1); PG8_STAGE(PG8_SB(1, 0), b3, voffB); PG8_STAGE(PG8_SB(1, 1), b3 + hstep, voffB); PG8_STAGE(PG8_SA(1, 0), a3, voffA);
            PG8_WAIT_V(8); PG8_WAIT_L(0); PG8_BAR; PG8_MMA(1, 0, At, B0); PG8_MMA(1, 1, At, B1); PG8_BAR; PG8_SCHED;
            } else {
            PG8_LDB(B0, 0, 0); PG8_SCHED; PG8_LDA(At, 0, 0); PG8_STAGE(PG8_SA(1, 1), a1 + hstep, voffA);
            PG8_WAIT_L(8); PG8_BAR; PG8_WAIT_L(0); PG8_MMA(0, 0, At, B0); PG8_BAR; PG8_SCHED;
            PG8_LDB(B1, 0, 1); PG8_STAGE(PG8_SB(0, 0), b2, voffB);
            PG8_BAR; PG8_WAIT_L(0); PG8_MMA(0, 1, At, B1); PG8_BAR;
            PG8_LDA(At, 0, 1); PG8_STAGE(PG8_SA(0, 0), a2, voffA);
            PG8_BAR; PG8_WAIT_L(0); PG8_MMA(1, 0, At, B0); PG8_BAR; PG8_SCHED;
            PG8_STAGE(PG8_SB(0, 1), b2 + hstep, voffB);
            PG8_WAIT_V(6); PG8_BAR; PG8_MMA(1, 1, At, B1); PG8_BAR;
            PG8_LDB(B0, 1, 0); PG8_SCHED; PG8_LDA(At, 1, 0); PG8_STAGE(PG8_SA(0, 1), a2 + hstep, voffA);
            PG8_WAIT_L(8); PG8_BAR; PG8_WAIT_L(0); PG8_MMA(0, 0, At, B0); PG8_BAR; PG8_SCHED;
            PG8_LDB(B1, 1, 1); PG8_STAGE(PG8_SB(1, 0), b3, voffB);
            PG8_BAR; PG8_WAIT_L(0); PG8_MMA(0, 1, At, B1); PG8_BAR;
            PG8_LDA(At, 1, 1); PG8_STAGE(PG8_SA(1, 0), a3, voffA);
            PG8_BAR; PG8_WAIT_L(0); PG8_MMA(1, 0, At, B0); PG8_BAR; PG8_SCHED;
            PG8_STAGE(PG8_SB(1, 1), b3 + hstep, voffB);
            PG8_WAIT_V(6); PG8_BAR; PG8_MMA(1, 1, At, B1); PG8_BAR;
            }
        }
        if constexpr (ALIGN_EPI) { if (wr == 0) PG8_BAR; }
        if constexpr (!Epi::AFTER_DRAIN) { E(acc, cur, wr, wc, fr, fq); S.done(cur); }
        if (!has_next) break;
#pragma unroll
        for (int a = 0; a < 2; ++a)
#pragma unroll
            for (int b = 0; b < 2; ++b)
#pragma unroll
                for (int m = 0; m < 4; ++m)
#pragma unroll
                    for (int n = 0; n < 2; ++n) acc[a][b][m][n] = (f32x4){0.f, 0.f, 0.f, 0.f};
        cur = nxt; cA = nA; cB = nB; ++ui;
        if constexpr (ALIGN_EPI) { if (wr == 1) PG8_BAR; }
    }
    PG8_WAIT_V(0);
    if constexpr (!ALIGN_EPI) { if (wr == 0) PG8_BAR; }
    PG8_BAR;
    if constexpr (Epi::AFTER_DRAIN) { E.fused(acc, cur, wr, wc, fr, fq, lds, wid, lane); S.done(cur); }
#undef PG8_SA
#undef PG8_SB
#undef PG8_STAGE
#undef PG8_LDA
#undef PG8_LDB
#undef PG8_MMA
#undef PG8_WAIT_V
#undef PG8_WAIT_L
#undef PG8_BAR
#undef PG8_SCHED
}
}

using pg8::bf16_t; using pg8::bf16x8; using pg8::f32x4; using pg8::u32x4; using pg8::cvt_pk_bf16; using pg8::f2bf1;
#define LAS __attribute__((address_space(3)))
using pg8::u32x2;
constexpr int D = 1024, NB = 32, SEQ = 2048, MTOK = NB * SEQ, DEPTH = 4;
constexpr int EVEN_IN = 2304, ODD_IN = 3104, ODD_INP = 3328;
constexpr int LDS_BYTES = 147456;
constexpr size_t MiB = 1u << 20;
constexpr size_t WS_MOD = 0;
constexpr size_t WS_WINA = 2 * MiB;
constexpr size_t WS_WOUTA = 12 * MiB;
constexpr size_t WS_WINC = 16 * MiB;
constexpr size_t WS_WOUTC = 30 * MiB;
constexpr size_t WS_WPT = 34 * MiB;
constexpr size_t WS_VT = 36 * MiB;
constexpr size_t WS_H = 64 * MiB;
constexpr size_t WS_OF = 192 * MiB;
constexpr size_t WS_OB = 320 * MiB;
constexpr size_t WS_PROJ = 448 * MiB;
constexpr size_t WS_HP = 840 * MiB;
constexpr size_t WS_ROWSS = 968 * MiB;
constexpr size_t WS_SHW = 970 * MiB;
constexpr size_t WS_SST = 972 * MiB;
constexpr size_t WS_END = 1004 * MiB;

__device__ __forceinline__ float bf2f(unsigned short b) { return __uint_as_float(((unsigned)b) << 16); }
__device__ __forceinline__ float bflo(unsigned w) { return __uint_as_float(w << 16); }
__device__ __forceinline__ float bfhi(unsigned w) { return __uint_as_float(w & 0xffff0000u); }
__device__ __forceinline__ float siluf(float z) { return z * __builtin_amdgcn_rcpf(1.0f + __builtin_amdgcn_exp2f(-1.4426950408889634f * z)); }
__device__ __forceinline__ f32x4 mfma16(bf16x8 a, bf16x8 b, f32x4 c) { return __builtin_amdgcn_mfma_f32_16x16x32_bf16(a, b, c, 0, 0, 0); }
__device__ __forceinline__ bf16x8 as_bf16x8(u32x4 v) { return __builtin_bit_cast(bf16x8, v); }

#define RLX_AGENT __ATOMIC_RELAXED, __HIP_MEMORY_SCOPE_AGENT
constexpr size_t WS_BAR = 1792 * 1024;
constexpr int LDS_MISC = 147456 - 64;
#define XB_TMO      128
#define XB_XCNT(j)  (256  + 64 * (j))
#define XB_XSUB(j)  (1280 + 64 * (j))
#define XB_XGEN(j)  (2304 + 64 * (j))
#define XB_TOP      3328
#define XB_TOPGEN   3392
#define XCD_BAR_WORDS 3456
#define XB_SPIN_CAP (1u << 18)

__device__ __forceinline__ unsigned xb_ld(unsigned* p)              { return __hip_atomic_load(p, __ATOMIC_RELAXED, __HIP_MEMORY_SCOPE_AGENT); }
__device__ __forceinline__ unsigned xb_add(unsigned* p, unsigned v) { return __hip_atomic_fetch_add(p, v, __ATOMIC_RELAXED, __HIP_MEMORY_SCOPE_AGENT); }
__device__ __forceinline__ unsigned xb_xcc_id() { return (unsigned)__builtin_amdgcn_s_getreg((3 << 11) | 20) & 0xFu; }
#define XB_SPIN(cond, bar) do { unsigned _sp = 0; while (cond) { __builtin_amdgcn_s_sleep(1); \
    if ((++_sp & 255u) == 0u) { if (xb_ld(&(bar)[XB_TMO])) break; if (_sp > XB_SPIN_CAP) { atomicAdd(&(bar)[XB_TMO], 1u); break; } } } } while (0)

struct XcdBarrier {
    unsigned* bar; unsigned x;
    volatile LAS unsigned* st;
};

__device__ __forceinline__ XcdBarrier xcd_barrier_post(unsigned* bar, volatile LAS unsigned* st) {
    XcdBarrier b; b.bar = bar; b.x = xb_xcc_id(); b.st = st;
    if (threadIdx.x == 0) (void)xb_add(&bar[XB_XCNT(b.x)], 1u);
    return b;
}
__device__ __forceinline__ void xcd_barrier_complete(unsigned* bar, unsigned x, unsigned& nloc, unsigned& nx) {
    const unsigned G = gridDim.x * gridDim.y * gridDim.z;
    unsigned sum, cnt, mine, sp = 0u;
    for (;;) {
        sum = 0u; cnt = 0u; mine = 0u;
#pragma unroll
        for (unsigned j = 0; j < 16; ++j) { const unsigned c = xb_ld(&bar[XB_XCNT(j)]); sum += c; cnt += (c > 0u) ? 1u : 0u; mine = (j == x) ? c : mine; }
        if (sum == G) break;
        __builtin_amdgcn_s_sleep(1);
        if ((++sp & 255u) == 0u) { if (xb_ld(&bar[XB_TMO])) break; if (sp > XB_SPIN_CAP) { atomicAdd(&bar[XB_TMO], 1u); break; } }
    }
    nloc = mine > 0u ? mine : 1u; nx = cnt > 0u ? cnt : 1u;
}

__device__ __forceinline__ void xcd_barrier(const XcdBarrier& b) {
    asm volatile("s_waitcnt vmcnt(0)" ::: "memory");
    __syncthreads();
    if (threadIdx.x == 0) {
        unsigned* bar = b.bar;
        __builtin_amdgcn_s_waitcnt(0);
        unsigned nloc = b.st[0], nx = b.st[1];
        if (nloc == 0u) { xcd_barrier_complete(bar, b.x, nloc, nx); b.st[0] = nloc; b.st[1] = nx; }
        const unsigned old = xb_add(&bar[XB_XSUB(b.x)], 1u);
        const unsigned gen = old / nloc;
        if (old + 1u == (gen + 1u) * nloc) {
            __builtin_amdgcn_fence(__ATOMIC_RELEASE, "agent");
            asm volatile("s_waitcnt vmcnt(0)" ::: "memory");
            const unsigned og = xb_add(&bar[XB_TOP], 1u);
            const unsigned tg = og / nx;
            if (og + 1u == (tg + 1u) * nx) xb_add(&bar[XB_TOPGEN], 1u);
            else XB_SPIN(xb_ld(&bar[XB_TOPGEN]) == tg, bar);
            __builtin_amdgcn_fence(__ATOMIC_ACQUIRE, "agent");
            xb_add(&bar[XB_XGEN(b.x)], 1u);
            asm volatile("s_waitcnt vmcnt(0)" ::: "memory");
        } else {
            XB_SPIN(xb_ld(&bar[XB_XGEN(b.x)]) == gen, bar);
            __builtin_amdgcn_fence(__ATOMIC_ACQUIRE, "agent");
            asm volatile("s_waitcnt vmcnt(0)" ::: "memory");
        }
    }
    __syncthreads();
}

#ifndef GEMM_SP2
#define GEMM_SP2 true
#endif
#ifndef GEMM_ALIGN
#define GEMM_ALIGN true
#endif
struct Ctx { int tid, lane, wid, vcu, G; };

__device__ __forceinline__ void small_gemm_item(LAS unsigned char* lds, const Ctx& X, const float* src, int srcS, bool use_silu, const float* W, int ldw, int ncols, int n0, const float* bias, float* out, int outS) {
    LAS float* SC = (LAS float*)lds;
    __syncthreads();
#pragma unroll
    for (int it = 0; it < 16; ++it) { const int t = X.tid + 512 * it, b = t >> 8, k4 = t & 255; f32x4 v = *(const f32x4*)(src + (size_t)b * srcS + 4 * k4);
        if (use_silu) { v[0] = siluf(v[0]); v[1] = siluf(v[1]); v[2] = siluf(v[2]); v[3] = siluf(v[3]); }
        *(LAS f32x4*)(SC + b * 1024 + 4 * k4) = v; }
    __syncthreads();
    float acc[32];
#pragma unroll
    for (int b = 0; b < 32; ++b) acc[b] = 0.f;
    const int nc = (n0 + X.lane < ncols) ? n0 + X.lane : ncols - 1;
    const float* wp = W + (size_t)(X.wid * 128) * ldw + nc;
#pragma unroll 4
    for (int k = 0; k < 128; k += 4) { const float w0 = wp[(size_t)k * ldw], w1 = wp[(size_t)(k + 1) * ldw], w2 = wp[(size_t)(k + 2) * ldw], w3 = wp[(size_t)(k + 3) * ldw];
#pragma unroll
        for (int b = 0; b < 32; ++b) { const f32x4 s4 = *(const LAS f32x4*)(SC + b * 1024 + X.wid * 128 + k); acc[b] += (s4[0] * w0 + s4[1] * w1) + (s4[2] * w2 + s4[3] * w3); } }
    __syncthreads();
    LAS float* RED = (LAS float*)lds;
#pragma unroll
    for (int b = 0; b < 32; ++b) RED[(X.wid * 32 + b) * 64 + X.lane] = acc[b];
    __syncthreads();
    for (int o = X.tid; o < 2048; o += 512) { const int b = o >> 6, nn = o & 63; float sv = bias ? bias[n0 + nn < ncols ? n0 + nn : ncols - 1] : 0.f;
#pragma unroll
        for (int w = 0; w < 8; ++w) sv += RED[(w * 32 + b) * 64 + nn];
        if (n0 + nn < ncols) out[(size_t)b * outS + n0 + nn] = sv; }
}
__device__ __forceinline__ void mod_phase(LAS unsigned char* lds, const Ctx& X, const float* c, const float* w_ada, const float* b_ada, float* mod) {
    for (int item = X.vcu; item < 192; item += X.G) { const int l = item / 48, n0 = (item % 48) * 64;
        small_gemm_item(lds, X, c, 1024, true, w_ada + (size_t)l * 1024 * 3072, 3072, 3072, n0, b_ada + l * 3072, mod + (size_t)l * 32 * 3072, 3072); }
    __syncthreads();
}
__device__ __forceinline__ void shiftw_phase(LAS unsigned char* lds, const Ctx& X, const float* mod, const float* w_in_a, const float* w_in_c, float* shw) {
    for (int item = X.vcu; item < 170; item += X.G) {
        int l, j; if (item < 36) { l = 0; j = item; } else if (item < 85) { l = 1; j = item - 36; } else if (item < 121) { l = 2; j = item - 85; } else { l = 3; j = item - 121; }
        const bool odd = (l & 1) != 0; const int N = odd ? ODD_IN : EVEN_IN;
        const float* W = odd ? w_in_c + (size_t)(l >> 1) * 1024 * ODD_IN : w_in_a + (size_t)(l >> 1) * 1024 * EVEN_IN;
        small_gemm_item(lds, X, mod + (size_t)l * 32 * 3072, 3072, false, W, N, N, j * 64, nullptr, shw + (size_t)l * 32 * 3328, 3328); }
    __syncthreads();
}

__device__ __forceinline__ void transpose_item(const float* W, int K, int N, bf16_t* WT, LAS float* scr, int item, int lane) {
    const int nblk = N / 32, kb = item / nblk, nb = item % nblk, k0 = 64 * kb, n0 = 32 * nb;
#pragma unroll 8
    for (int i = 0; i < 32; ++i) { const int kk = 2 * i + (lane >> 5); scr[kk * 33 + (lane & 31)] = W[(size_t)(k0 + kk) * N + n0 + (lane & 31)]; }
    asm volatile("s_waitcnt lgkmcnt(0)" ::: "memory");
    const int c = lane & 7;
#pragma unroll
    for (int j = 0; j < 4; ++j) { const int n = (lane >> 3) + 8 * j; const LAS float* s = scr + (8 * c) * 33 + n;
        u32x4 o; o.x = cvt_pk_bf16(s[0 * 33], s[1 * 33]); o.y = cvt_pk_bf16(s[2 * 33], s[3 * 33]); o.z = cvt_pk_bf16(s[4 * 33], s[5 * 33]); o.w = cvt_pk_bf16(s[6 * 33], s[7 * 33]);
        *(u32x4*)(WT + (size_t)(n0 + n) * K + k0 + 8 * c) = o; }
    asm volatile("s_waitcnt lgkmcnt(0)" ::: "memory");
}
struct WPtrs { const float *w_in_a, *w_out_a, *w_in_c, *w_out_c, *w_pool; };
__device__ __forceinline__ void transpose_phase(LAS unsigned char* lds, const Ctx& X, const WPtrs& P, unsigned char* ws) {
    LAS float* scr = (LAS float*)(lds + X.wid * 16384);
    const int gw = X.vcu * 8 + X.wid, NGW = X.G * 8;
    constexpr int I_INA = 16 * 72, I_OUT = 16 * 32, I_INC = 16 * 97, I_POOL = 2 * 4;
    constexpr int NITEMS = 2 * I_INA + 2 * I_OUT + 2 * I_INC + 2 * I_OUT + 8 * I_POOL;
    for (int it = gw; it < NITEMS; it += NGW) {
        int r = it;
        if (r < 2 * I_INA) { const int i = r / I_INA; transpose_item(P.w_in_a + (size_t)i * 1024 * EVEN_IN, 1024, EVEN_IN, (bf16_t*)(ws + WS_WINA) + (size_t)i * EVEN_IN * 1024, scr, r % I_INA, X.lane); continue; } r -= 2 * I_INA;
        if (r < 2 * I_OUT) { const int i = r / I_OUT; transpose_item(P.w_out_a + (size_t)i * 1024 * 1024, 1024, 1024, (bf16_t*)(ws + WS_WOUTA) + (size_t)i * 1024 * 1024, scr, r % I_OUT, X.lane); continue; } r -= 2 * I_OUT;
        if (r < 2 * I_INC) { const int i = r / I_INC; transpose_item(P.w_in_c + (size_t)i * 1024 * ODD_IN, 1024, ODD_IN, (bf16_t*)(ws + WS_WINC) + (size_t)i * ODD_INP * 1024, scr, r % I_INC, X.lane); continue; } r -= 2 * I_INC;
        if (r < 2 * I_OUT) { const int i = r / I_OUT; transpose_item(P.w_out_c + (size_t)i * 1024 * 1024, 1024, 1024, (bf16_t*)(ws + WS_WOUTC) + (size_t)i * 1024 * 1024, scr, r % I_OUT, X.lane); continue; } r -= 2 * I_OUT;
        { const int i = r / I_POOL; transpose_item(P.w_pool + (size_t)i * 16384, 128, 128, (bf16_t*)(ws + WS_WPT) + (size_t)i * 16384, scr, r % I_POOL, X.lane); }
    }
    for (int t = (X.vcu * 512 + X.tid); t < 2 * 224 * 128; t += X.G * 512) { const int i = t / (224 * 128), rr = t % (224 * 128);
        *(u32x4*)((bf16_t*)(ws + WS_WINC) + ((size_t)i * ODD_INP + ODD_IN) * 1024 + (size_t)rr * 8) = (u32x4){0u, 0u, 0u, 0u}; }
}

__device__ __forceinline__ float wave_sum(float v) {
#pragma unroll
    for (int o = 1; o < 64; o <<= 1) v += __shfl_xor(v, o);
    return v;
}
__device__ __forceinline__ void prenorm_phase(const Ctx& X, const float* x, const float* nw, const float* modl, bf16_t* hp, float* rowss) {
    const int gw = X.vcu * 8 + X.wid, NGW = X.G * 8;
#pragma unroll 2
    for (int m = gw; m < MTOK; m += NGW) {
        const int b = m >> 11;
        const f32x4* xr = (const f32x4*)(x + (size_t)m * D) + X.lane;
        f32x4 v[4]; float s = 0.f;
#pragma unroll
        for (int j = 0; j < 4; ++j) { v[j] = xr[64 * j]; s += (v[j][0] * v[j][0] + v[j][1] * v[j][1]) + (v[j][2] * v[j][2] + v[j][3] * v[j][3]); }
        s = wave_sum(s); if (X.lane == 0) rowss[m] = s;
        const f32x4* nwp = (const f32x4*)nw + X.lane; const f32x4* scp = (const f32x4*)(modl + b * 3072 + 1024) + X.lane;
        u32x2* o8 = (u32x2*)(hp + (size_t)m * D) + X.lane;
#pragma unroll
        for (int j = 0; j < 4; ++j) { const f32x4 y = v[j] * nwp[64 * j] * (scp[64 * j] + 1.0f);
            u32x2 o; o.x = cvt_pk_bf16(y[0], y[1]); o.y = cvt_pk_bf16(y[2], y[3]); o8[64 * j] = o; }
    }
}

template <int HW> __device__ __forceinline__ void pool_window(LAS unsigned char* lds, int U_OFF, int P_OFF, int US, int tid, int s0) {
    const int cp = tid & 63, t0 = 16 * (tid >> 6);
    constexpr int NR = 16 + 2 * HW - 1;
    unsigned rw[NR];
#pragma unroll
    for (int k = 0; k < NR; ++k) rw[k] = *(const LAS unsigned*)(lds + U_OFF + (t0 + 8 - HW + k) * US + cp * 4);
    float a0 = 0.f, a1 = 0.f;
#pragma unroll
    for (int k = 0; k < 2 * HW; ++k) { a0 += bflo(rw[k]); a1 += bfhi(rw[k]); }
#pragma unroll
    for (int it = 0; it < 16; ++it) { const int s = s0 + t0 + it;
        if (it > 0) { a0 += bflo(rw[2 * HW - 1 + it]) - bflo(rw[it - 1]); a1 += bfhi(rw[2 * HW - 1 + it]) - bfhi(rw[it - 1]); }
        int lo = s - HW, hi = s + HW - 1; lo = lo < 0 ? 0 : lo; hi = hi > SEQ - 1 ? SEQ - 1 : hi; const float inv = __builtin_amdgcn_rcpf((float)(hi - lo + 1));
        const unsigned uc = rw[HW + it];
        *(LAS unsigned*)(lds + P_OFF + (t0 + it) * US + cp * 4) = cvt_pk_bf16(a0 * inv - bflo(uc), a1 * inv - bfhi(uc)); }
}
__device__ __forceinline__ void pool_phase(LAS unsigned char* lds, const Ctx& X, const bf16_t* proj, const bf16_t* WpT, const float* pscale, bf16_t* mix) {
    constexpr int US = 272, U_OFF = 0, P_OFF = 144 * US, W_OFF = P_OFF + 128 * US;
    const int tid = X.tid, fr = X.lane & 15, fq = X.lane >> 4;
    u32x4 pu[5];
#define POOL_LOADU(item_) do { const int g_ = (item_) >> 9, tt_ = (item_) & 511, row0_ = tt_ * 128, b_ = row0_ >> 11, s0_ = row0_ & 2047; \
        _Pragma("unroll") for (int it = 0; it < 5; ++it) { const int t = tid + 512 * it, rr = t >> 4, pc = t & 15, s = s0_ - 8 + rr; pu[it] = (u32x4){0u, 0u, 0u, 0u}; \
            if (t < 144 * 16 && s >= 0 && s < SEQ) pu[it] = *(const u32x4*)(proj + ((size_t)b_ * SEQ + s) * EVEN_IN + g_ * 128 + pc * 8); } } while (0)
    if (X.vcu < 2048) POOL_LOADU(X.vcu);
    int gprev = -1;
    for (int item = X.vcu; item < 2048; item += X.G) {
        const int g = item >> 9, tt = item & 511, row0 = tt * 128, s0 = row0 & 2047; const bool neww = (g != gprev); gprev = g;
        const size_t tok = (size_t)row0 + 16 * X.wid + fr;
        u32x2 zr[8];
#pragma unroll
        for (int df = 0; df < 8; ++df) zr[df] = *(const u32x2*)(proj + tok * EVEN_IN + 512 + g * 128 + 16 * df + 4 * fq);
        u32x4 wv[4];
#pragma unroll
        for (int it = 0; it < 4; ++it) { const int t = tid + 512 * it, d = t >> 4, pc = t & 15; wv[it] = neww ? *(const u32x4*)(WpT + (size_t)g * 16384 + d * 128 + pc * 8) : (u32x4){0u, 0u, 0u, 0u}; }
        __syncthreads();
#pragma unroll
        for (int it = 0; it < 5; ++it) { const int t = tid + 512 * it, rr = t >> 4, pc = t & 15; if (t < 144 * 16) *(LAS u32x4*)(lds + U_OFF + rr * US + pc * 16) = pu[it]; }
        if (neww) {
#pragma unroll
        for (int it = 0; it < 4; ++it) { const int t = tid + 512 * it, d = t >> 4, pc = t & 15; *(LAS u32x4*)(lds + W_OFF + d * US + pc * 16) = wv[it]; } }
        { const int nxt = item + X.G < 2048 ? item + X.G : item; POOL_LOADU(nxt); }
        __syncthreads();
        if (g == 0) pool_window<1>(lds, U_OFF, P_OFF, US, tid, s0); else if (g == 1) pool_window<2>(lds, U_OFF, P_OFF, US, tid, s0);
        else if (g == 2) pool_window<4>(lds, U_OFF, P_OFF, US, tid, s0); else pool_window<8>(lds, U_OFF, P_OFF, US, tid, s0);
        __syncthreads();
        f32x4 acc[8];
#pragma unroll
        for (int df = 0; df < 8; ++df) acc[df] = (f32x4){0.f, 0.f, 0.f, 0.f};
#pragma unroll
        for (int ks = 0; ks < 4; ++ks) { const bf16x8 pb = *(const LAS bf16x8*)(lds + P_OFF + (16 * X.wid + fr) * US + ks * 64 + fq * 16);
#pragma unroll
            for (int df = 0; df < 8; ++df) { const bf16x8 wa = *(const LAS bf16x8*)(lds + W_OFF + (16 * df + fr) * US + ks * 64 + fq * 16); acc[df] = mfma16(wa, pb, acc[df]); } }
#pragma unroll
        for (int df = 0; df < 8; ++df) { const int c = g * 128 + 16 * df + 4 * fq; const f32x4 ps = *(const f32x4*)(pscale + c); const u32x2 z = zr[df];
            u32x2 o; o.x = cvt_pk_bf16(acc[df][0] * ps[0] * siluf(bflo(z.x)), acc[df][1] * ps[1] * siluf(bfhi(z.x))); o.y = cvt_pk_bf16(acc[df][2] * ps[2] * siluf(bflo(z.y)), acc[df][3] * ps[3] * siluf(bfhi(z.y)));
            *(u32x2*)(mix + tok * 1024 + c) = o; }
    }
#undef POOL_LOADU
    __syncthreads();
}

__device__ __forceinline__ void attn_phase(LAS unsigned char* lds, const Ctx& X, const bf16_t* proj, const bf16_t* VTg, const float* qw, const float* kw, const float* sink, bf16_t* mix) {
    constexpr int KS = 144, VS = 816, V_OFF = 384 * KS;
    const int tid = X.tid, wid = X.wid;
    for (int item = X.vcu; item < 1024; item += X.G) {
        const int kvh = item & 1, qb = (item >> 1) & 15, b = item >> 5, q0 = qb * 128; const size_t rowbase = (size_t)b * SEQ;
        __syncthreads();
#pragma unroll
        for (int it = 0; it < 6; ++it) { const int t = tid + 512 * it, jj = t >> 3, pc = t & 7, kpos = q0 - 128 + jj; u32x4 raw = (u32x4){0u, 0u, 0u, 0u};
            if (kpos >= 0 && kpos < SEQ) raw = *(const u32x4*)(proj + (rowbase + kpos) * EVEN_IN + 1536 + kvh * 64 + pc * 8);
            float f[8]; f[0] = bflo(raw.x); f[1] = bfhi(raw.x); f[2] = bflo(raw.y); f[3] = bfhi(raw.y); f[4] = bflo(raw.z); f[5] = bfhi(raw.z); f[6] = bflo(raw.w); f[7] = bfhi(raw.w);
            float ss = 0.f;
#pragma unroll
            for (int e = 0; e < 8; ++e) ss += f[e] * f[e];
            ss += __shfl_xor(ss, 1); ss += __shfl_xor(ss, 2); ss += __shfl_xor(ss, 4);
            const float r = 1.0f / sqrtf(ss * (1.f / 64.f) + 1e-6f);
            const f32x4 w0 = *(const f32x4*)(kw + pc * 8), w1 = *(const f32x4*)(kw + pc * 8 + 4);
            u32x4 o; o.x = cvt_pk_bf16(f[0] * r * w0[0], f[1] * r * w0[1]); o.y = cvt_pk_bf16(f[2] * r * w0[2], f[3] * r * w0[3]); o.z = cvt_pk_bf16(f[4] * r * w1[0], f[5] * r * w1[1]); o.w = cvt_pk_bf16(f[6] * r * w1[2], f[7] * r * w1[3]);
            *(LAS u32x4*)(lds + jj * KS + pc * 16) = o; }
#pragma unroll
        for (int it = 0; it < 7; ++it) { const int t = tid + 512 * it, d = t / 50, pc = t % 50, jj0 = pc * 8, kpos0 = q0 - 128 + jj0; u32x4 v = (u32x4){0u, 0u, 0u, 0u};
            if (t < 64 * 50 && jj0 < 384 && kpos0 >= 0 && kpos0 < SEQ) v = *(const u32x4*)(VTg + ((size_t)((b * 2 + kvh) * 64 + d)) * 2048 + kpos0);
            if (t < 64 * 50) *(LAS u32x4*)(lds + V_OFF + d * VS + pc * 16) = v; }
        __syncthreads();
        const int hq = kvh * 4 + (wid >> 1), qh = wid & 1;
        const float L2E = 1.4426950408889634f;
        const float slope2 = exp2f(-(float)(hq + 1)) * L2E, sink2 = sink[hq] * L2E;
        u32x4 qr0, qr1; u32x2 zr[4];
#define ATT_LOADQ(qf_) do { int l_ = X.lane; asm volatile("" : "+v"(l_)); const size_t tq_ = rowbase + q0 + (qh * 4 + (qf_)) * 16 + (l_ & 15); \
            const bf16_t* qp_ = proj + tq_ * EVEN_IN + 1024 + hq * 64 + (l_ >> 4) * 8; qr0 = *(const u32x4*)qp_; qr1 = *(const u32x4*)(qp_ + 32); \
            _Pragma("unroll") for (int df = 0; df < 4; ++df) zr[df] = *(const u32x2*)(proj + tq_ * EVEN_IN + 1792 + hq * 64 + 16 * df + 4 * (l_ >> 4)); } while (0)
        ATT_LOADQ(0);
#pragma unroll 1
        for (int qf = 0; qf < 4; ++qf) {
            int ln = X.lane; asm volatile("" : "+v"(ln)); const int fr = ln & 15, fq = ln >> 4;
            const int qfi = qh * 4 + qf, qo = qfi * 16; const size_t tq = rowbase + q0 + qo + fr;
            bf16x8 Q0, Q1; u32x2 zc[4];
            { const u32x4 r0 = qr0, r1 = qr1;
#pragma unroll
              for (int df = 0; df < 4; ++df) zc[df] = zr[df];
              float f[16]; f[0] = bflo(r0.x); f[1] = bfhi(r0.x); f[2] = bflo(r0.y); f[3] = bfhi(r0.y); f[4] = bflo(r0.z); f[5] = bfhi(r0.z); f[6] = bflo(r0.w); f[7] = bfhi(r0.w);
              f[8] = bflo(r1.x); f[9] = bfhi(r1.x); f[10] = bflo(r1.y); f[11] = bfhi(r1.y); f[12] = bflo(r1.z); f[13] = bfhi(r1.z); f[14] = bflo(r1.w); f[15] = bfhi(r1.w);
              float ss = 0.f;
#pragma unroll
              for (int e = 0; e < 16; ++e) ss += f[e] * f[e];
              ss += __shfl_xor(ss, 16); ss += __shfl_xor(ss, 32);
              const float r = (0.125f * L2E) * __builtin_amdgcn_rsqf(ss * (1.f / 64.f) + 1e-6f);
              const f32x4 wa = *(const f32x4*)(qw + fq * 8), wb = *(const f32x4*)(qw + fq * 8 + 4), wc_ = *(const f32x4*)(qw + 32 + fq * 8), wd = *(const f32x4*)(qw + 32 + fq * 8 + 4);
              u32x4 a, c2;
              a.x = cvt_pk_bf16(f[0] * r * wa[0], f[1] * r * wa[1]); a.y = cvt_pk_bf16(f[2] * r * wa[2], f[3] * r * wa[3]); a.z = cvt_pk_bf16(f[4] * r * wb[0], f[5] * r * wb[1]); a.w = cvt_pk_bf16(f[6] * r * wb[2], f[7] * r * wb[3]);
              c2.x = cvt_pk_bf16(f[8] * r * wc_[0], f[9] * r * wc_[1]); c2.y = cvt_pk_bf16(f[10] * r * wc_[2], f[11] * r * wc_[3]); c2.z = cvt_pk_bf16(f[12] * r * wd[0], f[13] * r * wd[1]); c2.w = cvt_pk_bf16(f[14] * r * wd[2], f[15] * r * wd[3]);
              Q0 = as_bf16x8(a); Q1 = as_bf16x8(c2); }
            ATT_LOADQ(qf < 3 ? qf + 1 : 3);
            f32x4 s[17];
#pragma unroll
            for (int kf = 0; kf < 17; ++kf) { const LAS unsigned char* kp = lds + ((qfi + kf) * 16 + fr) * KS + fq * 16;
                f32x4 a = (f32x4){0.f, 0.f, 0.f, 0.f}; a = mfma16(*(const LAS bf16x8*)kp, Q0, a); a = mfma16(*(const LAS bf16x8*)(kp + 64), Q1, a); s[kf] = a; }
            const int posq = q0 + qo + fr; const float tf = (float)(4 * fq - fr);
            const float lo = fmaxf(-128.f, -(float)posq), hi = fminf(128.f, (float)(SEQ - 1 - posq));
            float mx = sink2;
            if (qb == 0 || qb == 15) {
#pragma unroll
                for (int kf = 0; kf < 17; ++kf)
#pragma unroll
                    for (int e = 0; e < 4; ++e) { const float d = tf + (float)(16 * kf + e - 128); const bool valid = (d >= lo) && (d <= hi);
                        const float v = valid ? s[kf][e] - slope2 * fabsf(d) : -1e30f; s[kf][e] = v; mx = fmaxf(mx, v); }
            } else {
#pragma unroll
                for (int kf = 0; kf < 17; ++kf)
#pragma unroll
                    for (int e = 0; e < 4; ++e) { const float d = tf + (float)(16 * kf + e - 128); float v = s[kf][e] - slope2 * fabsf(d);
                        if (kf == 0) v = (d >= -128.f) ? v : -1e30f;
                        if (kf == 16) v = (d <= 128.f) ? v : -1e30f;
                        s[kf][e] = v; mx = fmaxf(mx, v); }
            }
            mx = fmaxf(mx, __shfl_xor(mx, 16)); mx = fmaxf(mx, __shfl_xor(mx, 32));
            float sum = 0.f;
#pragma unroll
            for (int kf = 0; kf < 17; ++kf)
#pragma unroll
                for (int e = 0; e < 4; ++e) { const float p = __builtin_amdgcn_exp2f(s[kf][e] - mx); s[kf][e] = p; sum += p; }
            sum += __shfl_xor(sum, 16); sum += __shfl_xor(sum, 32);
            const float inv = __builtin_amdgcn_rcpf(sum + __builtin_amdgcn_exp2f(sink2 - mx));
            f32x4 o[4];
#pragma unroll
            for (int df = 0; df < 4; ++df) o[df] = (f32x4){0.f, 0.f, 0.f, 0.f};
#pragma unroll
            for (int kp = 0; kp < 9; ++kp) { u32x4 pb; pb.x = cvt_pk_bf16(s[2 * kp][0], s[2 * kp][1]); pb.y = cvt_pk_bf16(s[2 * kp][2], s[2 * kp][3]);
                if (kp < 8) { pb.z = cvt_pk_bf16(s[(2 * kp + 1) % 17][0], s[(2 * kp + 1) % 17][1]); pb.w = cvt_pk_bf16(s[(2 * kp + 1) % 17][2], s[(2 * kp + 1) % 17][3]); } else { pb.z = 0u; pb.w = 0u; }
                const bf16x8 P = as_bf16x8(pb);
#pragma unroll
                for (int df = 0; df < 4; ++df) { const LAS unsigned char* vp = lds + V_OFF + (16 * df + fr) * VS + ((qfi + 2 * kp) * 16 + 4 * fq) * 2;
                    const u32x2 lo2 = *(const LAS u32x2*)vp, hi2 = *(const LAS u32x2*)(vp + 32); u32x4 va; va.x = lo2.x; va.y = lo2.y; va.z = hi2.x; va.w = hi2.y;
                    o[df] = mfma16(as_bf16x8(va), P, o[df]); } }
#pragma unroll
            for (int df = 0; df < 4; ++df) { const int c = hq * 64 + 16 * df + 4 * fq; const u32x2 z = zc[df];
                u32x2 ov; ov.x = cvt_pk_bf16(o[df][0] * inv * siluf(bflo(z.x)), o[df][1] * inv * siluf(bfhi(z.x))); ov.y = cvt_pk_bf16(o[df][2] * inv * siluf(bflo(z.y)), o[df][3] * inv * siluf(bfhi(z.y)));
                *(u32x2*)(mix + tq * 1024 + 512 + c) = ov; }
        }
#undef ATT_LOADQ
    }
    __syncthreads();
}

template <int CTRL> __device__ __forceinline__ float dpp_f32(float v) { return __builtin_bit_cast(float, __builtin_amdgcn_update_dpp(0, __builtin_bit_cast(int, v), CTRL, 0xf, 0xf, false)); }
__device__ __forceinline__ void gla_phase(LAS unsigned char* lds, const Ctx& X, const bf16_t* proj, const float* Wg, const float* bg, bf16_t* OF, bf16_t* OB, float* SST, bool ph2, const float* gw, bf16_t* mix) {
    constexpr int RS = 272, TS = 144;
    constexpr int QA = 0, KA = 64 * RS, QX = 2 * 64 * RS, KXT = 3 * 64 * RS, VT = KXT + 128 * TS, ATT = VT + 256 * TS, DEC = ATT + 64 * TS, AW = DEC + 512, PART = AW + 2048;
    static_assert(PART + 2048 <= 147392, "gla lds");
    const int wid = X.wid;
    const float sc = 0.08838834764831845f;
    for (int item = X.vcu; item < 256; item += X.G) {
        const int half = item & 1, hd = (item >> 1) & 3, b = item >> 3, dir = ph2 ? 1 - half : half;
        bf16_t* obuf = dir ? OB : OF; const bf16_t* other = dir ? OF : OB;
        float* sst = SST + ((size_t)((b * 4 + hd) * 2 + dir)) * 32768 + (size_t)wid * 4096;
#define CHUNK(n_) (ph2 ? (dir ? 15 - (n_) : 16 + (n_)) : (dir ? 31 - (n_) : (n_)))
        __syncthreads();
        bf16x8 WgA;
        { const int fr_ = X.lane & 15, fq_ = X.lane >> 4; float wv[8];
#pragma unroll
          for (int j = 0; j < 8; ++j) wv[j] = (fq_ < 2) ? Wg[(size_t)(dir * 16 + 8 * (fq_ & 1) + j) * 512 + hd * 128 + 16 * wid + fr_] : 0.f;
          u32x4 p; p.x = cvt_pk_bf16(wv[0], wv[1]); p.y = cvt_pk_bf16(wv[2], wv[3]); p.z = cvt_pk_bf16(wv[4], wv[5]); p.w = cvt_pk_bf16(wv[6], wv[7]); WgA = as_bf16x8(p); }
        const f32x4 bgv = *(const f32x4*)(bg + dir * 512 + hd * 128 + 16 * wid + 4 * (X.lane >> 4));
        f32x4 S[8][2];
#pragma unroll
        for (int kf = 0; kf < 8; ++kf)
#pragma unroll
            for (int vf = 0; vf < 2; ++vf) S[kf][vf] = ph2 ? *(const f32x4*)(sst + ((kf * 2 + vf) * 64 + X.lane) * 4) : (f32x4){0.f, 0.f, 0.f, 0.f};
        u32x4 pa1 = (u32x4){0u, 0u, 0u, 0u}, raq[2], rak[2]; u32x2 pv[2][4];
#define TOKC(cc, i) ((size_t)b * SEQ + (size_t)(cc) * 64 + (size_t)(dir ? 63 - (i) : (i)))
#define GLA_LOADS(cc) do { int tl = X.tid; asm volatile("" : "+v"(tl)); const int l_ = tl & 63, rbl_ = l_ & 3, cql_ = l_ >> 2; \
            if (tl < 128) pa1 = *(const u32x4*)(proj + TOKC(cc, tl >> 1) * ODD_IN + 3072 + dir * 16 + (tl & 1) * 8); \
            _Pragma("unroll") for (int t = 0; t < 2; ++t) { const int pi = tl + 512 * t; const bf16_t* pp = proj + TOKC(cc, pi >> 4) * ODD_IN + hd * 128 + (pi & 15) * 8; raq[t] = *(const u32x4*)pp; rak[t] = *(const u32x4*)(pp + 512); } \
            _Pragma("unroll") for (int p = 0; p < 2; ++p) { const int ps = 2 * wid + p, rbg = ps >> 2, cg = ps & 3; \
                _Pragma("unroll") for (int r = 0; r < 4; ++r) pv[p][r] = *(const u32x2*)(proj + TOKC(cc, 4 * (4 * rbg + rbl_) + r) * ODD_IN + 1024 + hd * 256 + 4 * (16 * cg + cql_)); } } while (0)
#define GLA_STAGE_A() do { int tl = X.tid; asm volatile("" : "+v"(tl)); if (tl < 128) *(LAS u32x4*)(lds + AW + (tl >> 1) * 32 + (tl & 1) * 16) = pa1; } while (0)
#define GLA_STAGE_QK() do { int tl = X.tid; asm volatile("" : "+v"(tl)); _Pragma("unroll") for (int t = 0; t < 2; ++t) { const int pi = tl + 512 * t; \
            *(LAS u32x4*)(lds + QA + (pi >> 4) * RS + (pi & 15) * 16) = raq[t]; *(LAS u32x4*)(lds + KA + (pi >> 4) * RS + (pi & 15) * 16) = rak[t]; } } while (0)
        GLA_LOADS(CHUNK(0));
        GLA_STAGE_A(); GLA_STAGE_QK();
        __syncthreads();
#pragma unroll 1
        for (int n = 0; n < 16; ++n) {
            const int c = CHUNK(n); const int nn = n < 15 ? n + 1 : 15, cnx = CHUNK(nn);
            int tid = X.tid; asm volatile("" : "+v"(tid)); const int lane = tid & 63, fr = lane & 15, fq = lane >> 4, rb = fr, cs = fq;
            u32x2 pq[4], pk[4];
#pragma unroll
            for (int r = 0; r < 4; ++r) { const int ro = (4 * rb + r) * RS + (16 * wid + 4 * cs) * 2; pq[r] = *(const LAS u32x2*)(lds + QA + ro); pk[r] = *(const LAS u32x2*)(lds + KA + ro); }
            { const int rbl = lane & 3, cql = lane >> 2;
#pragma unroll
              for (int p = 0; p < 2; ++p) { const int ps = 2 * wid + p, rbg = ps >> 2, cg = ps & 3; LAS unsigned char* vp = lds + VT + (4 * (16 * cg + cql)) * TS + (4 * (4 * rbg + rbl)) * 2;
                  u32x2 w;
                  w.x = (pv[p][0].x & 0xffffu) | (pv[p][1].x << 16); w.y = (pv[p][2].x & 0xffffu) | (pv[p][3].x << 16); *(LAS u32x2*)(vp) = w;
                  w.x = (pv[p][0].x >> 16) | (pv[p][1].x & 0xffff0000u); w.y = (pv[p][2].x >> 16) | (pv[p][3].x & 0xffff0000u); *(LAS u32x2*)(vp + TS) = w;
                  w.x = (pv[p][0].y & 0xffffu) | (pv[p][1].y << 16); w.y = (pv[p][2].y & 0xffffu) | (pv[p][3].y << 16); *(LAS u32x2*)(vp + 2 * TS) = w;
                  w.x = (pv[p][0].y >> 16) | (pv[p][1].y & 0xffff0000u); w.y = (pv[p][2].y >> 16) | (pv[p][3].y & 0xffff0000u); *(LAS u32x2*)(vp + 3 * TS) = w; } }
            GLA_LOADS(cnx);
            float x[4][4];
#pragma unroll
            for (int t = 0; t < 4; ++t) { u32x4 av = *(const LAS u32x4*)(lds + AW + (4 * rb + t) * 32 + (fq & 1) * 16); if (fq >= 2) av = (u32x4){0u, 0u, 0u, 0u};
                const f32x4 xa = mfma16(WgA, as_bf16x8(av), bgv);
                x[t][0] = xa[0]; x[t][1] = xa[1]; x[t][2] = xa[2]; x[t][3] = xa[3]; }
            float tot[4], inc[4];
#pragma unroll
            for (int cc = 0; cc < 4; ++cc) { float run = 0.f;
#pragma unroll
                for (int r = 0; r < 4; ++r) { const float xv = x[r][cc]; run += (fminf(xv, 0.f) * 1.4426950408889634f - __builtin_amdgcn_logf(1.0f + __builtin_amdgcn_exp2f(-1.4426950408889634f * fabsf(xv)))) * 0.0625f; x[r][cc] = run; }
                tot[cc] = run; inc[cc] = run; }
#pragma unroll
            for (int cc = 0; cc < 4; ++cc) { inc[cc] += dpp_f32<0x111>(inc[cc]); inc[cc] += dpp_f32<0x112>(inc[cc]); inc[cc] += dpp_f32<0x114>(inc[cc]); inc[cc] += dpp_f32<0x118>(inc[cc]); }
            float blast[4], ref[4];
#pragma unroll
            for (int cc = 0; cc < 4; ++cc) { const float ex = inc[cc] - tot[cc];
#pragma unroll
                for (int r = 0; r < 4; ++r) x[r][cc] += ex;
                blast[cc] = __shfl(inc[cc], (lane & 48) | 15); ref[cc] = __shfl(x[0][cc], (lane & 48) | 8); }
            { float kx[4][4], eref[4], elr[4];
#pragma unroll
              for (int cc = 0; cc < 4; ++cc) { eref[cc] = __builtin_amdgcn_exp2f(ref[cc]); elr[cc] = __builtin_amdgcn_exp2f(blast[cc] - ref[cc]); }
#pragma unroll
              for (int r = 0; r < 4; ++r) { const float q4[4] = {bflo(pq[r].x) * sc, bfhi(pq[r].x) * sc, bflo(pq[r].y) * sc, bfhi(pq[r].y) * sc}; const float k4[4] = {bflo(pk[r].x), bfhi(pk[r].x), bflo(pk[r].y), bfhi(pk[r].y)};
                  float qa[4], ka[4], qx[4];
#pragma unroll
                  for (int cc = 0; cc < 4; ++cc) { const float e1 = __builtin_amdgcn_exp2f(x[r][cc] - ref[cc]), e2 = __builtin_amdgcn_rcpf(e1); qa[cc] = q4[cc] * e1; ka[cc] = k4[cc] * e2; qx[cc] = qa[cc] * eref[cc]; kx[r][cc] = ka[cc] * elr[cc]; }
                  const int ro = (4 * rb + r) * RS + (16 * wid + 4 * cs) * 2;
                  u32x2 w; w.x = cvt_pk_bf16(qa[0], qa[1]); w.y = cvt_pk_bf16(qa[2], qa[3]); *(LAS u32x2*)(lds + QA + ro) = w;
                  w.x = cvt_pk_bf16(ka[0], ka[1]); w.y = cvt_pk_bf16(ka[2], ka[3]); *(LAS u32x2*)(lds + KA + ro) = w;
                  w.x = cvt_pk_bf16(qx[0], qx[1]); w.y = cvt_pk_bf16(qx[2], qx[3]); *(LAS u32x2*)(lds + QX + ro) = w; }
#pragma unroll
              for (int cc = 0; cc < 4; ++cc) { u32x2 w; w.x = cvt_pk_bf16(kx[0][cc], kx[1][cc]); w.y = cvt_pk_bf16(kx[2][cc], kx[3][cc]);
                  *(LAS u32x2*)(lds + KXT + (16 * wid + 4 * cs + cc) * TS + (4 * rb) * 2) = w; }
              if (rb == 0) *(LAS f32x4*)(lds + DEC + (16 * wid + 4 * cs) * 4) = (f32x4){__builtin_amdgcn_exp2f(blast[0]), __builtin_amdgcn_exp2f(blast[1]), __builtin_amdgcn_exp2f(blast[2]), __builtin_amdgcn_exp2f(blast[3])}; }
            __syncthreads();
            u32x2 ov[4][2];
            if (ph2) {
#pragma unroll
                for (int fi = 0; fi < 4; ++fi) { const size_t tk = TOKC(c, 16 * fi + fr);
#pragma unroll
                    for (int vf = 0; vf < 2; ++vf) ov[fi][vf] = *(const u32x2*)(other + tk * 1024 + hd * 256 + 32 * wid + 4 * fq + 16 * vf); } }
            { const int fi = wid >> 1, fj0 = 2 * (wid & 1); f32x4 a0 = (f32x4){0.f, 0.f, 0.f, 0.f}, a1 = (f32x4){0.f, 0.f, 0.f, 0.f};
#pragma unroll
              for (int ks = 0; ks < 4; ++ks) { const bf16x8 qf_ = *(const LAS bf16x8*)(lds + QA + (16 * fi + fr) * RS + ks * 64 + fq * 16);
                  if (fj0 <= fi) a0 = mfma16(qf_, *(const LAS bf16x8*)(lds + KA + (16 * fj0 + fr) * RS + ks * 64 + fq * 16), a0);
                  if (fj0 + 1 <= fi) a1 = mfma16(qf_, *(const LAS bf16x8*)(lds + KA + (16 * (fj0 + 1) + fr) * RS + ks * 64 + fq * 16), a1); }
#pragma unroll
              for (int e = 0; e < 4; ++e) { const int i = 16 * fi + 4 * fq + e, j0 = 16 * fj0 + fr, j1 = j0 + 16; const bool k0 = dir ? (j0 < i) : (j0 <= i), k1 = dir ? (j1 < i) : (j1 <= i);
                  *(LAS unsigned short*)(lds + ATT + i * TS + j0 * 2) = f2bf1(k0 ? a0[e] : 0.f); *(LAS unsigned short*)(lds + ATT + i * TS + j1 * 2) = f2bf1(k1 ? a1[e] : 0.f); } }
            bf16x8 vb[2][2];
#pragma unroll
            for (int vf = 0; vf < 2; ++vf)
#pragma unroll
                for (int ks = 0; ks < 2; ++ks) vb[vf][ks] = *(const LAS bf16x8*)(lds + VT + (32 * wid + 16 * vf + fr) * TS + ks * 64 + fq * 16);
            f32x4 o[4][2];
#pragma unroll
            for (int fi = 0; fi < 4; ++fi) { o[fi][0] = (f32x4){0.f, 0.f, 0.f, 0.f}; o[fi][1] = (f32x4){0.f, 0.f, 0.f, 0.f}; }
#pragma unroll
            for (int a4 = 0; a4 < 4; ++a4) { bf16x8 sb[2];
#pragma unroll
                for (int vf = 0; vf < 2; ++vf) { u32x4 p; p.x = cvt_pk_bf16(S[2 * a4][vf][0], S[2 * a4][vf][1]); p.y = cvt_pk_bf16(S[2 * a4][vf][2], S[2 * a4][vf][3]); p.z = cvt_pk_bf16(S[2 * a4 + 1][vf][0], S[2 * a4 + 1][vf][1]); p.w = cvt_pk_bf16(S[2 * a4 + 1][vf][2], S[2 * a4 + 1][vf][3]); sb[vf] = as_bf16x8(p); }
#pragma unroll
                for (int fi = 0; fi < 4; ++fi) { const LAS unsigned char* qp = lds + QX + (16 * fi + fr) * RS + (32 * a4 + 4 * fq) * 2; const u32x2 lo = *(const LAS u32x2*)qp, hi = *(const LAS u32x2*)(qp + 32);
                    u32x4 qa; qa.x = lo.x; qa.y = lo.y; qa.z = hi.x; qa.w = hi.y; const bf16x8 Bq = as_bf16x8(qa); o[fi][0] = mfma16(sb[0], Bq, o[fi][0]); o[fi][1] = mfma16(sb[1], Bq, o[fi][1]); } }
#pragma unroll
            for (int kf = 0; kf < 8; ++kf) { const f32x4 d4 = *(const LAS f32x4*)((const LAS float*)(lds + DEC) + 16 * kf + 4 * fq); S[kf][0] *= d4; S[kf][1] *= d4; }
#pragma unroll
            for (int ks = 0; ks < 2; ++ks)
#pragma unroll
                for (int kf = 0; kf < 8; ++kf) { const bf16x8 a = *(const LAS bf16x8*)(lds + KXT + (16 * kf + fr) * TS + ks * 64 + fq * 16); S[kf][0] = mfma16(a, vb[0][ks], S[kf][0]); S[kf][1] = mfma16(a, vb[1][ks], S[kf][1]); }
            GLA_STAGE_A();
            __syncthreads();
#pragma unroll
            for (int ks = 0; ks < 2; ++ks)
#pragma unroll
                for (int fi = 0; fi < 4; ++fi) { const bf16x8 a = *(const LAS bf16x8*)(lds + ATT + (16 * fi + fr) * TS + ks * 64 + fq * 16); o[fi][0] = mfma16(vb[0][ks], a, o[fi][0]); o[fi][1] = mfma16(vb[1][ks], a, o[fi][1]); }
            u32x2 zv[4][2];
            if (!ph2) {
#pragma unroll
                for (int fi = 0; fi < 4; ++fi) { bf16_t* op = obuf + TOKC(c, 16 * fi + fr) * 1024 + hd * 256 + 32 * wid + 4 * fq;
#pragma unroll
                    for (int vf = 0; vf < 2; ++vf) { u32x2 w; w.x = cvt_pk_bf16(o[fi][vf][0], o[fi][vf][1]); w.y = cvt_pk_bf16(o[fi][vf][2], o[fi][vf][3]); *(u32x2*)(op + 16 * vf) = w; } }
            } else {
#pragma unroll
                for (int fi = 0; fi < 4; ++fi) { const size_t tk = TOKC(c, 16 * fi + fr);
#pragma unroll
                    for (int vf = 0; vf < 2; ++vf) zv[fi][vf] = *(const u32x2*)(proj + tk * ODD_IN + 2048 + hd * 256 + 32 * wid + 4 * fq + 16 * vf); }
#pragma unroll
                for (int fi = 0; fi < 4; ++fi) { float ss = 0.f;
#pragma unroll
                    for (int vf = 0; vf < 2; ++vf) { o[fi][vf][0] += bflo(ov[fi][vf].x); o[fi][vf][1] += bfhi(ov[fi][vf].x); o[fi][vf][2] += bflo(ov[fi][vf].y); o[fi][vf][3] += bfhi(ov[fi][vf].y);
                        ss += (o[fi][vf][0] * o[fi][vf][0] + o[fi][vf][1] * o[fi][vf][1]) + (o[fi][vf][2] * o[fi][vf][2] + o[fi][vf][3] * o[fi][vf][3]); }
                    ss += __shfl_xor(ss, 16); ss += __shfl_xor(ss, 32);
                    if (fq == 0) ((LAS float*)(lds + PART))[wid * 64 + 16 * fi + fr] = ss; }
            }
            GLA_STAGE_QK();
            __syncthreads();
            if (ph2) {
                const f32x4 gw0 = *(const f32x4*)(gw + 32 * wid + 4 * fq), gw1 = *(const f32x4*)(gw + 32 * wid + 16 + 4 * fq);
#pragma unroll
                for (int fi = 0; fi < 4; ++fi) { float tot = 0.f;
#pragma unroll
                    for (int w = 0; w < 8; ++w) tot += ((const LAS float*)(lds + PART))[w * 64 + 16 * fi + fr];
                    const float r = __builtin_amdgcn_rsqf(tot * (1.f / 256.f) + 1e-6f);
                    bf16_t* mp = mix + TOKC(c, 16 * fi + fr) * 1024 + hd * 256 + 32 * wid + 4 * fq;
#pragma unroll
                    for (int vf = 0; vf < 2; ++vf) { const f32x4 gv = vf ? gw1 : gw0; const u32x2 z = zv[fi][vf];
                        u32x2 w; w.x = cvt_pk_bf16(o[fi][vf][0] * r * gv[0] * siluf(bflo(z.x)), o[fi][vf][1] * r * gv[1] * siluf(bfhi(z.x))); w.y = cvt_pk_bf16(o[fi][vf][2] * r * gv[2] * siluf(bflo(z.y)), o[fi][vf][3] * r * gv[3] * siluf(bfhi(z.y)));
                        *(u32x2*)(mp + 16 * vf) = w; } }
                        }
        }
        if (!ph2) {
#pragma unroll
            for (int kf = 0; kf < 8; ++kf)
#pragma unroll
                for (int vf = 0; vf < 2; ++vf) *(f32x4*)(sst + ((kf * 2 + vf) * 64 + X.lane) * 4) = S[kf][vf]; }
#undef CHUNK
#undef GLA_STAGE_A
#undef GLA_STAGE_QK
#undef GLA_LOADS
#undef TOKC
    }
}
__device__ __forceinline__ void gla_finish_phase(const Ctx& X, const bf16_t* OF, const bf16_t* OB, const bf16_t* proj, const float* gw, bf16_t* mix) {
    const int gwv = X.vcu * 8 + X.wid, NGW = X.G * 8, col0 = X.lane * 16;
    f32x4 w4[4];
#pragma unroll
    for (int q = 0; q < 4; ++q) w4[q] = *(const f32x4*)(gw + (col0 & 255) + 4 * q);
#pragma unroll 2
    for (int m = gwv; m < MTOK; m += NGW) {
        const u32x4* pf = (const u32x4*)(OF + (size_t)m * 1024 + col0); const u32x4* pb = (const u32x4*)(OB + (size_t)m * 1024 + col0); const u32x4* pz = (const u32x4*)(proj + (size_t)m * ODD_IN + 2048 + col0);
        float v[16], z[16]; float ss = 0.f;
#pragma unroll
        for (int h = 0; h < 2; ++h) { const u32x4 a = pf[h], c = pb[h], zz = pz[h];
            v[8 * h + 0] = bflo(a.x) + bflo(c.x); v[8 * h + 1] = bfhi(a.x) + bfhi(c.x); v[8 * h + 2] = bflo(a.y) + bflo(c.y); v[8 * h + 3] = bfhi(a.y) + bfhi(c.y);
            v[8 * h + 4] = bflo(a.z) + bflo(c.z); v[8 * h + 5] = bfhi(a.z) + bfhi(c.z); v[8 * h + 6] = bflo(a.w) + bflo(c.w); v[8 * h + 7] = bfhi(a.w) + bfhi(c.w);
            z[8 * h + 0] = bflo(zz.x); z[8 * h + 1] = bfhi(zz.x); z[8 * h + 2] = bflo(zz.y); z[8 * h + 3] = bfhi(zz.y); z[8 * h + 4] = bflo(zz.z); z[8 * h + 5] = bfhi(zz.z); z[8 * h + 6] = bflo(zz.w); z[8 * h + 7] = bfhi(zz.w); }
#pragma unroll
        for (int e = 0; e < 16; ++e) ss += v[e] * v[e];
        ss += __shfl_xor(ss, 1); ss += __shfl_xor(ss, 2); ss += __shfl_xor(ss, 4); ss += __shfl_xor(ss, 8);
        const float r = 1.0f / sqrtf(ss * (1.f / 256.f) + 1e-6f);
        float y[16];
#pragma unroll
        for (int e = 0; e < 16; ++e) y[e] = v[e] * r * w4[e >> 2][e & 3] * siluf(z[e]);
        u32x4 o0, o1; o0.x = cvt_pk_bf16(y[0], y[1]); o0.y = cvt_pk_bf16(y[2], y[3]); o0.z = cvt_pk_bf16(y[4], y[5]); o0.w = cvt_pk_bf16(y[6], y[7]);
        o1.x = cvt_pk_bf16(y[8], y[9]); o1.y = cvt_pk_bf16(y[10], y[11]); o1.z = cvt_pk_bf16(y[12], y[13]); o1.w = cvt_pk_bf16(y[14], y[15]);
        u32x4* po = (u32x4*)(mix + (size_t)m * 1024 + col0); po[0] = o0; po[1] = o1;
    }
}

struct Args { const float* in[17]; float* out; unsigned char* ws; int ph_lo, ph_hi; };
constexpr int N_PHASES = 2 + 6 * DEPTH;
__global__ void __launch_bounds__(512, 2) fwd_mega(Args args) {
    extern __shared__ __attribute__((aligned(16))) unsigned char lds_raw[];
    LAS unsigned char* lds = (LAS unsigned char*)lds_raw;
    cg::grid_group grid = cg::this_grid();
    Ctx X; X.tid = threadIdx.x; X.lane = X.tid & 63; X.wid = __builtin_amdgcn_readfirstlane(X.tid >> 6); X.G = gridDim.x;
    { const int bx = blockIdx.x; X.vcu = (X.G % 8 == 0) ? (bx % 8) * (X.G / 8) + bx / 8 : bx; }
    const float* x_in = args.in[0]; const float* c_in = args.in[1]; const float* norm_w = args.in[2]; const float* w_ada = args.in[3]; const float* b_ada = args.in[4];
    const float* pool_scale = args.in[7]; const float* q_norm_w = args.in[8]; const float* k_norm_w = args.in[9]; const float* attn_sink = args.in[10];
    const float* w_gate_up = args.in[13]; const float* b_gate = args.in[14]; const float* gla_norm_w = args.in[15];
    unsigned char* ws = args.ws; float* out = args.out;
    float* mod = (float*)(ws + WS_MOD); bf16_t* H = (bf16_t*)(ws + WS_H); bf16_t* PROJ = (bf16_t*)(ws + WS_PROJ); bf16_t* VTg = (bf16_t*)(ws + WS_VT); bf16_t* OF = (bf16_t*)(ws + WS_OF); bf16_t* OB = (bf16_t*)(ws + WS_OB);
    bf16_t* HP = (bf16_t*)(ws + WS_HP); float* ROWSS = (float*)(ws + WS_ROWSS); float* SHW = (float*)(ws + WS_SHW);
    const int lo = args.ph_lo, hi = args.ph_hi;
    if (threadIdx.x < 16) ((LAS unsigned*)(lds + LDS_MISC))[threadIdx.x] = 0u;
    __syncthreads();
    XcdBarrier bar = xcd_barrier_post((unsigned*)(ws + WS_BAR), (volatile LAS unsigned*)(lds + LDS_MISC));
    const bool one = (hi - lo) > 1;
#define IN(k) (lo <= (k) && (k) < hi)
#define FRESH(Y) Ctx Y = X; asm volatile("" : "+v"(Y.tid), "+v"(Y.lane))
#define SEAM(k) do { if (one && IN((k) + 1)) xcd_barrier(bar); } while (0)
    if (hi < 0) grid.sync();
    if (IN(0)) { FRESH(Y); mod_phase(lds, Y, c_in, w_ada, b_ada, mod); SEAM(0); }
    if (IN(1)) { WPtrs P{args.in[5], args.in[11], args.in[12], args.in[16], args.in[6]}; FRESH(Y); shiftw_phase(lds, Y, mod, args.in[5], args.in[12], SHW); transpose_phase(lds, Y, P, ws); __syncthreads();
        prenorm_phase(Y, x_in, norm_w, mod, HP, ROWSS); SEAM(1); }
#pragma unroll 1
    for (int l = 0; l < DEPTH; ++l) {
        const int pb = 2 + 6 * l, i2 = l >> 1; const bool odd = (l & 1) != 0;
        const float* xsrc = (l == 0) ? x_in : out; const float* modl = mod + (size_t)l * 32 * 3072;
        if (IN(pb + 1)) {
            const bf16_t* Ap = HP; const bf16_t* Bp = (const bf16_t*)(ws + (odd ? WS_WINC : WS_WINA)) + (size_t)i2 * (odd ? ODD_INP : EVEN_IN) * 1024; asm volatile("" : "+s"(Ap), "+s"(Bp));
            if (!odd) { pg8::Gemm g{Ap, Bp, MTOK, EVEN_IN, D}; pg8::StaticOrder S; S.init(MTOK, EVEN_IN, X.G, (int)blockIdx.x);
                pg8::EpiProj E{PROJ, EVEN_IN, EVEN_IN, VTg, ROWSS + (size_t)l * MTOK, SHW + (size_t)l * 32 * 3328}; pg8::gemm_phase<pg8::EpiProj, pg8::StaticOrder, GEMM_ALIGN, GEMM_SP2>(lds, g, S, E); }
            else { pg8::Gemm g{Ap, Bp, MTOK, ODD_INP, D}; pg8::StaticOrder S; S.init(MTOK, ODD_INP, X.G, (int)blockIdx.x);
                pg8::EpiProj E{PROJ, ODD_IN, ODD_IN, nullptr, ROWSS + (size_t)l * MTOK, SHW + (size_t)l * 32 * 3328}; pg8::gemm_phase<pg8::EpiProj, pg8::StaticOrder, GEMM_ALIGN, GEMM_SP2>(lds, g, S, E); }
            SEAM(pb + 1);
        }
        if (IN(pb + 2)) {
#ifdef DUP_MIX
            for (int rep = 0; rep < 2; ++rep) {
#endif
            FRESH(Y); if (!odd) { pool_phase(lds, Y, PROJ, (const bf16_t*)(ws + WS_WPT) + (size_t)i2 * 4 * 16384, pool_scale + i2 * 512, H);
                attn_phase(lds, Y, PROJ, VTg, q_norm_w + i2 * 64, k_norm_w + i2 * 64, attn_sink + i2 * 8, H); }
            else gla_phase(lds, Y, PROJ, w_gate_up + (size_t)i2 * 2 * 16 * 512, b_gate + i2 * 2 * 512, OF, OB, (float*)(ws + WS_SST), false, gla_norm_w + i2 * 256, H);
#ifdef DUP_MIX
            }
#endif
            SEAM(pb + 2);
        }
        if (IN(pb + 3)) { FRESH(Y); if (odd) gla_phase(lds, Y, PROJ, w_gate_up + (size_t)i2 * 2 * 16 * 512, b_gate + i2 * 2 * 512, OF, OB, (float*)(ws + WS_SST), true, gla_norm_w + i2 * 256, H); if (odd) SEAM(pb + 3); }
        if (IN(pb + 4)) {
            const bf16_t* Ap = H; const bf16_t* Bp = (const bf16_t*)(ws + (odd ? WS_WOUTC : WS_WOUTA)) + (size_t)i2 * 1024 * 1024; asm volatile("" : "+s"(Ap), "+s"(Bp));
            pg8::Gemm g{Ap, Bp, MTOK, D, D}; pg8::StaticOrder S; S.init(MTOK, D, X.G, (int)blockIdx.x);
            pg8::EpiOut E{xsrc, out, modl + 2048, (l + 1 < DEPTH) ? HP : nullptr, norm_w + (l + 1) * 1024, modl + 32 * 3072 + 1024, ROWSS + (size_t)(l + 1) * MTOK}; pg8::gemm_phase<pg8::EpiOut, pg8::StaticOrder, GEMM_ALIGN, GEMM_SP2>(lds, g, S, E);
            if (l + 1 < DEPTH) { if (one && IN(pb + 6)) xcd_barrier(bar); }
        }
    }
#undef IN
#undef SEAM
}

#ifndef MK_ONE_LAUNCH
#define MK_ONE_LAUNCH 1
#endif
extern "C" void kernel_launch(void* const* d_in, const int* in_sizes, int n_in, void* d_out, int out_size, void* d_ws, size_t ws_size, hipStream_t stream) {
    static int grid = 0;
    if (grid == 0) {
        int dev = 0, cus = 0, per_cu = 0;
        if (hipGetDevice(&dev) != hipSuccess || hipDeviceGetAttribute(&cus, hipDeviceAttributeMultiprocessorCount, dev) != hipSuccess) { fprintf(stderr, "kernel_launch: device query failed\n"); grid = -1; return; }
        if (hipFuncSetAttribute((const void*)fwd_mega, hipFuncAttributeMaxDynamicSharedMemorySize, LDS_BYTES) != hipSuccess) { fprintf(stderr, "kernel_launch: hipFuncSetAttribute failed\n"); grid = -1; return; }
        if (hipOccupancyMaxActiveBlocksPerMultiprocessor(&per_cu, (const void*)fwd_mega, 512, LDS_BYTES) != hipSuccess || per_cu < 1) fprintf(stderr, "kernel_launch: occupancy query reports %d\n", per_cu);
        (void)hipGetLastError();
        if (n_in != 17 || out_size != MTOK * D || ws_size < WS_END) { fprintf(stderr, "kernel_launch: unexpected shapes (n_in %d out %d ws %zu)\n", n_in, out_size, ws_size); grid = -1; return; }
        grid = cus;
    }
    if (grid < 0) return;
    if (hipMemsetAsync((unsigned char*)d_ws + WS_BAR, 0, 16384, stream) != hipSuccess) fprintf(stderr, "kernel_launch: memset failed\n");
    if (hipMemsetAsync((unsigned char*)d_ws + WS_ROWSS, 0, 4 * MTOK * sizeof(float), stream) != hipSuccess) fprintf(stderr, "kernel_launch: memset failed\n");
    Args a{};
    for (int i = 0; i < 17; ++i) a.in[i] = (const float*)d_in[i];
    a.out = (float*)d_out; a.ws = (unsigned char*)d_ws;
#if MK_ONE_LAUNCH
    a.ph_lo = 0; a.ph_hi = N_PHASES;
    void* kargs[] = {&a};
    hipError_t e = hipLaunchCooperativeKernel((void*)fwd_mega, dim3(grid), dim3(512), kargs, LDS_BYTES, stream);
    if (e != hipSuccess) fprintf(stderr, "kernel_launch: cooperative launch failed: %s (grid %d)\n", hipGetErrorString(e), grid);
#else
    for (int p = 0; p < N_PHASES; ++p) { const int q = (p - 2) % 6; if (p >= 2 && (q == 5 || q == 0 || (q == 3 && (((p - 2) / 6) & 1) == 0))) continue;
        a.ph_lo = p; a.ph_hi = p + 1; void* kargs[] = {&a};
        hipError_t e = hipLaunchCooperativeKernel((void*)fwd_mega, dim3(grid), dim3(512), kargs, LDS_BYTES, stream);
        if (e != hipSuccess) { fprintf(stderr, "kernel_launch: launch of phase %d failed: %s\n", p, hipGetErrorString(e)); break; } }
#endif
}
```

```cpp
#include <hip/hip_runtime.h>
#include <hip/hip_cooperative_groups.h>
#include <cstdio>
namespace cg = cooperative_groups;

namespace pg8 {
#define PG8_LAS __attribute__((address_space(3)))
typedef unsigned short bf16_t;
typedef short bf16x8 __attribute__((ext_vector_type(8)));
typedef float f32x4 __attribute__((ext_vector_type(4)));
typedef unsigned u32x4 __attribute__((ext_vector_type(4)));
typedef unsigned u32x2 __attribute__((ext_vector_type(2)));
constexpr int BM = 256, BK = 64, HALF = 128, HTB = HALF * BK * 2  , STAGE_BYTES = 8 * HTB, NXCD = 8, WGM = 8;

__host__ __device__ __forceinline__ int lds_byte(int r, int c) { const int st = (r >> 4) * 2 + (c >> 5), rr = r & 15, cc = c & 31, ob = rr * 64 + cc * 2; return st * 1024 + (ob ^ (((ob >> 9) & 1) << 5)); }
__host__ __device__ __forceinline__ void stage_rc(int b, int& R, int& C) { const int st = b / 1024, sb = b % 1024, swz = sb ^ (((sb >> 9) & 1) << 5); R = (st >> 1) * 16 + swz / 64; C = (st & 1) * 32 + (swz % 64) / 2; }
__host__ __device__ __forceinline__ int perm32(int rho) { const int n = rho >> 4, i = rho & 15; return 8 * (i >> 2) + 4 * n + (i & 3); }

struct Unit { int pm, pn; };
struct Gemm { const bf16_t* A; const bf16_t* Bt; int M, N, K; };

struct StaticOrder {
    int nM, nN, nwg, G, c;
    __host__ __device__ void init(int M, int N, int G_, int c_) { nM = M / BM; nN = N / BM; nwg = nM * nN; G = G_; c = c_; }
    __host__ __device__ bool next(int i, Unit& u) const {
        const long L = (long)i * G + c; if (L >= nwg) return false;
        int wgid = (int)L; { const int q = nwg / NXCD, r = nwg % NXCD, xcd = wgid % NXCD, off = wgid / NXCD; wgid = (xcd < r ? xcd * (q + 1) : r * (q + 1) + (xcd - r) * q) + off; }
        const int nig = WGM * nN, gid = wgid / nig, fm = gid * WGM, gsz = (nM - fm) < WGM ? (nM - fm) : WGM;
        u.pm = fm + ((wgid % nig) % gsz); u.pn = (wgid % nig) / gsz; return true;
    }
    __device__ __forceinline__ void a_ready(const Unit&) const {}
    __device__ __forceinline__ void done(const Unit&) const {}
};

typedef __bf16 bf16v2_t __attribute__((ext_vector_type(2)));
typedef float f32v2_t __attribute__((ext_vector_type(2)));
__device__ __forceinline__ unsigned cvt_pk_bf16(float lo, float hi) { const f32v2_t v = {lo, hi}; const bf16v2_t b = __builtin_convertvector(v, bf16v2_t); return __builtin_bit_cast(unsigned, b); }
__device__ __forceinline__ unsigned short f2bf1(float f) { return (unsigned short)(cvt_pk_bf16(f, 0.f) & 0xffffu); }

struct EpiProj {
    static constexpr bool PERM = true, AFTER_DRAIN = false;
    bf16_t* O; int ldc; int ncols; bf16_t* VT; const float* rowss; const float* shw;
    __device__ __forceinline__ void operator()(const f32x4 (&acc)[2][2][4][2], const Unit& u, int wr, int wc, int fr, int fq) const {
        const int row0 = u.pm * BM + wr * 64 + fr, col0 = u.pn * BM + wc * 32 + 8 * fq;
        const bool dov = (VT != nullptr) && (u.pn == 6);
        const int vc = wc * 32 + 8 * fq, b = (u.pm * BM) >> 11;
        bf16_t* vbase = VT + ((size_t)((b * 2 + (vc >> 6)) * 64 + (vc & 63))) * 2048 + (row0 & 2047);
        f32x4 sh[2][2];
#pragma unroll
        for (int bj = 0; bj < 2; ++bj) { sh[bj][0] = *(const f32x4*)(shw + b * 3328 + col0 + bj * HALF); sh[bj][1] = *(const f32x4*)(shw + b * 3328 + col0 + bj * HALF + 4); }
        float rs[2][4];
#pragma unroll
        for (int ai = 0; ai < 2; ++ai)
#pragma unroll
            for (int m = 0; m < 4; ++m) rs[ai][m] = rowss[row0 + ai * HALF + m * 16];
#pragma unroll
        for (int ai = 0; ai < 2; ++ai)
#pragma unroll
            for (int m = 0; m < 4; ++m) { const int row = row0 + ai * HALF + m * 16; bf16_t* rowp = O + (size_t)row * ldc + col0;
                const float r = __builtin_amdgcn_rsqf(rs[ai][m] * (1.0f / 1024.0f) + 1e-6f);
#pragma unroll
                for (int bj = 0; bj < 2; ++bj) { const f32x4 v0 = acc[ai][bj][m][0] * r + sh[bj][0], v1 = acc[ai][bj][m][1] * r + sh[bj][1];
                    u32x4 w; w.x = cvt_pk_bf16(v0[0], v0[1]); w.y = cvt_pk_bf16(v0[2], v0[3]); w.z = cvt_pk_bf16(v1[0], v1[1]); w.w = cvt_pk_bf16(v1[2], v1[3]);
                    if (col0 + bj * HALF < ncols) *(u32x4*)(rowp + bj * HALF) = w;
                    if (bj == 1 && dov) { bf16_t* vp = vbase + ai * HALF + m * 16;
                        vp[0 * 2048] = (bf16_t)(w.x & 0xffffu); vp[1 * 2048] = (bf16_t)(w.x >> 16); vp[2 * 2048] = (bf16_t)(w.y & 0xffffu); vp[3 * 2048] = (bf16_t)(w.y >> 16);
                        vp[4 * 2048] = (bf16_t)(w.z & 0xffffu); vp[5 * 2048] = (bf16_t)(w.z >> 16); vp[6 * 2048] = (bf16_t)(w.w & 0xffffu); vp[7 * 2048] = (bf16_t)(w.w >> 16); } }
                asm volatile("" ::: "memory"); }
    }
};
struct EpiOut {
    static constexpr bool PERM = false, AFTER_DRAIN = false;
    const float* xin; float* xout; const float* gate;
    bf16_t* hp; const float* nwn; const float* scn; float* rssn;
    __device__ __forceinline__ void operator()(const f32x4 (&acc)[2][2][4][2], const Unit& u, int wr, int wc, int fr, int fq) const {
        const int row0 = u.pm * BM + wr * 64 + fr, col0 = u.pn * BM + wc * 32 + 4 * fq, b = (u.pm * BM) >> 11;
        const bool nx = hp != nullptr;
        f32x4 g[2][2], ws[2][2];
#pragma unroll
        for (int bj = 0; bj < 2; ++bj)
#pragma unroll
            for (int n = 0; n < 2; ++n) { const int c = col0 + bj * HALF + n * 16; g[bj][n] = *(const f32x4*)(gate + b * 3072 + c);
                ws[bj][n] = nx ? *(const f32x4*)(nwn + c) * (*(const f32x4*)(scn + b * 3072 + c) + 1.0f) : (f32x4){0.f, 0.f, 0.f, 0.f}; }
#pragma unroll
        for (int ai = 0; ai < 2; ++ai)
#pragma unroll
            for (int m = 0; m < 4; ++m) { const int row = row0 + ai * HALF + m * 16; const size_t off = (size_t)row * 1024 + col0; float ss = 0.f;
#pragma unroll
                for (int bj = 0; bj < 2; ++bj)
#pragma unroll
                    for (int n = 0; n < 2; ++n) { const f32x4 xo = *(const f32x4*)(xin + off + bj * HALF + n * 16); const f32x4 xn = xo + g[bj][n] * acc[ai][bj][m][n];
                        *(f32x4*)(xout + off + bj * HALF + n * 16) = xn;
                        if (nx) { ss += (xn[0] * xn[0] + xn[1] * xn[1]) + (xn[2] * xn[2] + xn[3] * xn[3]); const f32x4 h = xn * ws[bj][n];
                            u32x2 w; w.x = cvt_pk_bf16(h[0], h[1]); w.y = cvt_pk_bf16(h[2], h[3]); *(u32x2*)(hp + off + bj * HALF + n * 16) = w; } }
                if (nx) { ss += __shfl_xor(ss, 16); ss += __shfl_xor(ss, 32); if (fq == 0) atomicAdd(rssn + row, ss); }
                asm volatile("" ::: "memory"); }
    }
};

template <class Epi, class Sched, bool ALIGN_EPI = false, bool SP2 = false>
__device__ __forceinline__ void gemm_phase(PG8_LAS unsigned char* lds, const Gemm g, const Sched& S, const Epi& E) {
    int tid_ = threadIdx.x; asm volatile("" : "+v"(tid_));
    const int tid = tid_, wid = __builtin_amdgcn_readfirstlane(tid >> 6), lane = tid & 63, wr = wid >> 2, wc = wid & 3, fr = lane & 15, fq = lane >> 4;
    const int K = g.K, nt = K / BK;
    unsigned voffA[2], voffB[2];
#pragma unroll
    for (int i = 0; i < 2; ++i) { int R, C; stage_rc(tid * 16 + i * 8192, R, C); const int Rb = Epi::PERM ? ((R & ~31) + perm32(R & 31)) : R;
        voffA[i] = (unsigned)(R * K + C) * 2u; voffB[i] = (unsigned)(Rb * K + C) * 2u; }
    const size_t kstep = (size_t)(BK * 2);
    const size_t hstep = (size_t)HALF * K * 2;
    const size_t tstep = 2 * hstep;
    const unsigned ldsw = (unsigned)wid * 1024u;
    const int aoff = lds_byte(wr * 64 + fr, fq * 8), boff = lds_byte(wc * 32 + fr, fq * 8);
#define PG8_SA(b, h) (((b) * 2 + (h)) * HTB)
#define PG8_SB(b, h) ((4 + (b) * 2 + (h)) * HTB)
#define PG8_STAGE(bufoff, gbase, voff) do { _Pragma("unroll") for (int _i = 0; _i < 2; ++_i) \
        __builtin_amdgcn_global_load_lds((const unsigned*)((const char*)(gbase) + (voff)[_i]), (PG8_LAS unsigned*)(lds + (bufoff) + ldsw + _i * 8192), 16, 0, 0); } while (0)
#define PG8_LDA(dst, b, h) do { _Pragma("unroll") for (int m = 0; m < 4; ++m) _Pragma("unroll") for (int k = 0; k < 2; ++k) dst[m][k] = *(const PG8_LAS bf16x8*)(lds + PG8_SA(b, h) + aoff + m * 2048 + k * 1024); } while (0)
#define PG8_LDB(dst, b, h) do { _Pragma("unroll") for (int n = 0; n < 2; ++n) _Pragma("unroll") for (int k = 0; k < 2; ++k) dst[n][k] = *(const PG8_LAS bf16x8*)(lds + PG8_SB(b, h) + boff + n * 2048 + k * 1024); } while (0)
#define PG8_MMA(ai, bj, At, Bt) do { __builtin_amdgcn_s_setprio(1); _Pragma("unroll") for (int m = 0; m < 4; ++m) _Pragma("unroll") for (int n = 0; n < 2; ++n) _Pragma("unroll") for (int k = 0; k < 2; ++k) \
        acc[ai][bj][m][n] = __builtin_amdgcn_mfma_f32_16x16x32_bf16(Bt[n][k], At[m][k], acc[ai][bj][m][n], 0, 0, 0); __builtin_amdgcn_s_setprio(0); } while (0)
#define PG8_WAIT_V(n) asm volatile("s_waitcnt vmcnt(" #n ")" ::: "memory")
#define PG8_WAIT_L(n) asm volatile("s_waitcnt lgkmcnt(" #n ")" ::: "memory")
#define PG8_BAR __builtin_amdgcn_s_barrier()
#define PG8_SCHED __builtin_amdgcn_sched_barrier(0)
    Unit cur, nxt; int ui = 0;
    if (!S.next(0, cur)) return;
    f32x4 acc[2][2][4][2];
#pragma unroll
    for (int a = 0; a < 2; ++a)
#pragma unroll
        for (int b = 0; b < 2; ++b)
#pragma unroll
            for (int m = 0; m < 4; ++m)
#pragma unroll
                for (int n = 0; n < 2; ++n) acc[a][b][m][n] = (f32x4){0.f, 0.f, 0.f, 0.f};
    bf16x8 At[4][2], B0[2][2], B1[2][2];
    const char* cA = (const char*)g.A + (size_t)cur.pm * tstep; const char* cB = (const char*)g.Bt + (size_t)cur.pn * tstep;
    S.a_ready(cur);
    if constexpr (SP2) {
        PG8_STAGE(PG8_SB(0, 0), cB, voffB); PG8_STAGE(PG8_SB(0, 1), cB + hstep, voffB); PG8_STAGE(PG8_SA(0, 0), cA, voffA); PG8_STAGE(PG8_SA(0, 1), cA + hstep, voffA);
        if (wr == 1) PG8_BAR;
        PG8_WAIT_V(2); PG8_BAR;
        PG8_STAGE(PG8_SB(1, 0), cB + kstep, voffB); PG8_STAGE(PG8_SA(1, 0), cA + kstep, voffA); PG8_STAGE(PG8_SB(1, 1), cB + hstep + kstep, voffB);
        PG8_WAIT_V(6); PG8_BAR;
    } else {
        PG8_STAGE(PG8_SB(0, 0), cB, voffB); PG8_STAGE(PG8_SA(0, 0), cA, voffA); PG8_STAGE(PG8_SB(0, 1), cB + hstep, voffB); PG8_STAGE(PG8_SA(0, 1), cA + hstep, voffA);
        if (wr == 1) PG8_BAR;
        PG8_WAIT_V(4); PG8_BAR;
        PG8_STAGE(PG8_SB(1, 0), cB + kstep, voffB); PG8_STAGE(PG8_SA(1, 0), cA + kstep, voffA); PG8_STAGE(PG8_SB(1, 1), cB + hstep + kstep, voffB);
        PG8_WAIT_V(6); PG8_BAR;
    }
    for (;;) {
        const bool has_next = S.next(ui + 1, nxt);
        const char* nA = has_next ? (const char*)g.A + (size_t)nxt.pm * tstep : cA; const char* nB = has_next ? (const char*)g.Bt + (size_t)nxt.pn * tstep : cB;
        for (int t = 0; t < nt; t += 2) {
            const bool last = (t == nt - 2);
            const char* a1 = cA + (size_t)(t + 1) * kstep;
            const char* a2 = last ? nA : cA + (size_t)(t + 2) * kstep; const char* b2 = last ? nB : cB + (size_t)(t + 2) * kstep;
            const char* a3 = a2 + kstep; const char* b3 = b2 + kstep;
            if (last && has_next) S.a_ready(nxt);
            if constexpr (SP2) {
            PG8_LDB(B0, 0, 0); PG8_LDB(B1, 0, 1); PG8_SCHED; PG8_LDA(At, 0, 0); PG8_STAGE(PG8_SA(1, 1), a1 + hstep, voffA);
            PG8_WAIT_V(8); PG8_WAIT_L(0); PG8_BAR; PG8_MMA(0, 0, At, B0); PG8_MMA(0, 1, At, B1); PG8_BAR; PG8_SCHED;
            PG8_LDA(At, 0, 1); PG8_STAGE(PG8_SB(0, 0), b2, voffB); PG8_STAGE(PG8_SB(0, 1), b2 + hstep, voffB); PG8_STAGE(PG8_SA(0, 0), a2, voffA);
            PG8_WAIT_V(8); PG8_WAIT_L(0); PG8_BAR; PG8_MMA(1, 0, At, B0); PG8_MMA(1, 1, At, B1); PG8_BAR; PG8_SCHED;
            PG8_LDB(B0, 1, 0); PG8_LDB(B1, 1, 1); PG8_SCHED; PG8_LDA(At, 1, 0); PG8_STAGE(PG8_SA(0, 1), a2 + hstep, voffA);
            PG8_WAIT_V(8); PG8_WAIT_L(0); PG8_BAR; PG8_MMA(0, 0, At, B0); PG8_MMA(0, 1, At, B1); PG8_BAR; PG8_SCHED;
            PG8_LDA(At, 1, 1); PG8_STAGE(PG8_SB(1, 0), b3, voffB); PG8_STAGE(PG8_SB(1, 1), b3 + hstep, voffB); PG8_STAGE(PG8_SA(1, 0), a3, voffA);
            PG8_WAIT_V(8); PG8_WAIT_L(0); PG8_BAR; PG8_MMA(1, 0, At, B0); PG8_MMA(1, 1, At, B1); PG8_BAR; PG8_SCHED;
            } else {
            PG8_LDB(B0, 0, 0); PG8_SCHED; PG8_LDA(At, 0, 0); PG8_STAGE(PG8_SA(1, 1), a1 + hstep, voffA);
            PG8_WAIT_L(8); PG8_BAR; PG8_WAIT_L(0); PG8_MMA(0, 0, At, B0); PG8_BAR; PG8_SCHED;
            PG8_LDB(B1, 0, 1); PG8_STAGE(PG8_SB(0, 0), b2, voffB);
            PG8_BAR; PG8_WAIT_L(0); PG8_MMA(0, 1, At, B1); PG8_BAR;
            PG8_LDA(At, 0, 1); PG8_STAGE(PG8_SA(0, 0), a2, voffA);
            PG8_BAR; PG8_WAIT_L(0); PG8_MMA(1, 0, At, B0); PG8_BAR; PG8_SCHED;
            PG8_STAGE(PG8_SB(0, 1), b2 + hstep, voffB);
            PG8_WAIT_V(6); PG8_BAR; PG8_MMA(1, 1, At, B1); PG8_BAR;
            PG8_LDB(B0, 1, 0); PG8_SCHED; PG8_LDA(At, 1, 0); PG8_STAGE(PG8_SA(0, 1), a2 + hstep, voffA);
            PG8_WAIT_L(8); PG8_BAR; PG8_WAIT_L(0); PG8_MMA(0, 0, At, B0); PG8_BAR; PG8_SCHED;
            PG8_LDB(B1, 1, 1); PG8_STAGE(PG8_SB(1, 0), b3, voffB);
            PG8_BAR; PG8_WAIT_L(0); PG8_MMA(0, 1, At, B1); PG8_BAR;
            PG8_LDA(At, 1, 1); PG8_STAGE(PG8_SA(1, 0), a3, voffA);
            PG8_BAR; PG8_WAIT_L(0); PG8_MMA(1, 0, At, B0); PG8_BAR; PG8_SCHED;
            PG8_STAGE(PG8_SB(1, 1), b3 + hstep, voffB);
            PG8_WAIT_V(6); PG8_BAR; PG8_MMA(1, 1, At, B1); PG8_BAR;
            }
        }
        if constexpr (ALIGN_EPI) { if (wr == 0) PG8_BAR; }
        if constexpr (!Epi::AFTER_DRAIN) { E(acc, cur, wr, wc, fr, fq); S.done(cur); }
        if (!has_next) break;
#pragma unroll
        for (int a = 0; a < 2; ++a)
#pragma unroll
            for (int b = 0; b < 2; ++b)
#pragma unroll
                for (int m = 0; m < 4; ++m)
#pragma unroll
                    for (int n = 0; n < 2; ++n) acc[a][b][m][n] = (f32x4){0.f, 0.f, 0.f, 0.f};
        cur = nxt; cA = nA; cB = nB; ++ui;
        if constexpr (ALIGN_EPI) { if (wr == 1) PG8_BAR; }
    }
    PG8_WAIT_V(0);
    if constexpr (!ALIGN_EPI) { if (wr == 0) PG8_BAR; }
    PG8_BAR;
    if constexpr (Epi::AFTER_DRAIN) { E.fused(acc, cur, wr, wc, fr, fq, lds, wid, lane); S.done(cur); }
#undef PG8_SA
#undef PG8_SB
#undef PG8_STAGE
#undef PG8_LDA
#undef PG8_LDB
#undef PG8_MMA
#undef PG8_WAIT_V
#undef PG8_WAIT_L
#undef PG8_BAR
#undef PG8_SCHED
}
}

using pg8::bf16_t; using pg8::bf16x8; using pg8::f32x4; using pg8::u32x4; using pg8::cvt_pk_bf16; using pg8::f2bf1;
#define LAS __attribute__((address_space(3)))
using pg8::u32x2;
constexpr int D = 1024, NB = 32, SEQ = 2048, MTOK = NB * SEQ, DEPTH = 4;
constexpr int EVEN_IN = 2304, ODD_IN = 3104, ODD_INP = 3328;
constexpr int LDS_BYTES = 147456;
constexpr size_t MiB = 1u << 20;
constexpr size_t WS_MOD = 0;
constexpr size_t WS_WINA = 2 * MiB;
constexpr size_t WS_WOUTA = 12 * MiB;
constexpr size_t WS_WINC = 16 * MiB;
constexpr size_t WS_WOUTC = 30 * MiB;
constexpr size_t WS_WPT = 34 * MiB;
constexpr size_t WS_VT = 36 * MiB;
constexpr size_t WS_H = 64 * MiB;
constexpr size_t WS_OF = 192 * MiB;
constexpr size_t WS_OB = 320 * MiB;
constexpr size_t WS_PROJ = 448 * MiB;
constexpr size_t WS_HP = 840 * MiB;
constexpr size_t WS_ROWSS = 968 * MiB;
constexpr size_t WS_SHW = 970 * MiB;
constexpr size_t WS_SST = 972 * MiB;
constexpr size_t WS_END = 1004 * MiB;

__device__ __forceinline__ float bf2f(unsigned short b) { return __uint_as_float(((unsigned)b) << 16); }
__device__ __forceinline__ float bflo(unsigned w) { return __uint_as_float(w << 16); }
__device__ __forceinline__ float bfhi(unsigned w) { return __uint_as_float(w & 0xffff0000u); }
__device__ __forceinline__ float siluf(float z) { return z * __builtin_amdgcn_rcpf(1.0f + __builtin_amdgcn_exp2f(-1.4426950408889634f * z)); }
__device__ __forceinline__ f32x4 mfma16(bf16x8 a, bf16x8 b, f32x4 c) { return __builtin_amdgcn_mfma_f32_16x16x32_bf16(a, b, c, 0, 0, 0); }
__device__ __forceinline__ bf16x8 as_bf16x8(u32x4 v) { return __builtin_bit_cast(bf16x8, v); }

#define RLX_AGENT __ATOMIC_RELAXED, __HIP_MEMORY_SCOPE_AGENT
constexpr size_t WS_BAR = 1792 * 1024;
constexpr int LDS_MISC = 147456 - 64;
#define XB_TMO      128
#define XB_XCNT(j)  (256  + 64 * (j))
#define XB_XSUB(j)  (1280 + 64 * (j))
#define XB_XGEN(j)  (2304 + 64 * (j))
#define XB_TOP      3328
#define XB_TOPGEN   3392
#define XCD_BAR_WORDS 3456
#define XB_SPIN_CAP (1u << 18)

__device__ __forceinline__ unsigned xb_ld(unsigned* p)              { return __hip_atomic_load(p, __ATOMIC_RELAXED, __HIP_MEMORY_SCOPE_AGENT); }
__device__ __forceinline__ unsigned xb_add(unsigned* p, unsigned v) { return __hip_atomic_fetch_add(p, v, __ATOMIC_RELAXED, __HIP_MEMORY_SCOPE_AGENT); }
__device__ __forceinline__ unsigned xb_xcc_id() { return (unsigned)__builtin_amdgcn_s_getreg((3 << 11) | 20) & 0xFu; }
#define XB_SPIN(cond, bar) do { unsigned _sp = 0; while (cond) { __builtin_amdgcn_s_sleep(1); \
    if ((++_sp & 255u) == 0u) { if (xb_ld(&(bar)[XB_TMO])) break; if (_sp > XB_SPIN_CAP) { atomicAdd(&(bar)[XB_TMO], 1u); break; } } } } while (0)

struct XcdBarrier {
    unsigned* bar; unsigned x;
    volatile LAS unsigned* st;
};

__device__ __forceinline__ XcdBarrier xcd_barrier_post(unsigned* bar, volatile LAS unsigned* st) {
    XcdBarrier b; b.bar = bar; b.x = xb_xcc_id(); b.st = st;
    if (threadIdx.x == 0) (void)xb_add(&bar[XB_XCNT(b.x)], 1u);
    return b;
}
__device__ __forceinline__ void xcd_barrier_complete(unsigned* bar, unsigned x, unsigned& nloc, unsigned& nx) {
    const unsigned G = gridDim.x * gridDim.y * gridDim.z;
    unsigned sum, cnt, mine, sp = 0u;
    for (;;) {
        sum = 0u; cnt = 0u; mine = 0u;
#pragma unroll
        for (unsigned j = 0; j < 16; ++j) { const unsigned c = xb_ld(&bar[XB_XCNT(j)]); sum += c; cnt += (c > 0u) ? 1u : 0u; mine = (j == x) ? c : mine; }
        if (sum == G) break;
        __builtin_amdgcn_s_sleep(1);
        if ((++sp & 255u) == 0u) { if (xb_ld(&bar[XB_TMO])) break; if (sp > XB_SPIN_CAP) { atomicAdd(&bar[XB_TMO], 1u); break; } }
    }
    nloc = mine > 0u ? mine : 1u; nx = cnt > 0u ? cnt : 1u;
}

__device__ __forceinline__ void xcd_barrier(const XcdBarrier& b) {
    asm volatile("s_waitcnt vmcnt(0)" ::: "memory");
    __syncthreads();
    if (threadIdx.x == 0) {
        unsigned* bar = b.bar;
        __builtin_amdgcn_s_waitcnt(0);
        unsigned nloc = b.st[0], nx = b.st[1];
        if (nloc == 0u) { xcd_barrier_complete(bar, b.x, nloc, nx); b.st[0] = nloc; b.st[1] = nx; }
        const unsigned old = xb_add(&bar[XB_XSUB(b.x)], 1u);
        const unsigned gen = old / nloc;
        if (old + 1u == (gen + 1u) * nloc) {
            __builtin_amdgcn_fence(__ATOMIC_RELEASE, "agent");
            asm volatile("s_waitcnt vmcnt(0)" ::: "memory");
            const unsigned og = xb_add(&bar[XB_TOP], 1u);
            const unsigned tg = og / nx;
            if (og + 1u == (tg + 1u) * nx) xb_add(&bar[XB_TOPGEN], 1u);
            else XB_SPIN(xb_ld(&bar[XB_TOPGEN]) == tg, bar);
            __builtin_amdgcn_fence(__ATOMIC_ACQUIRE, "agent");
            xb_add(&bar[XB_XGEN(b.x)], 1u);
            asm volatile("s_waitcnt vmcnt(0)" ::: "memory");
        } else {
            XB_SPIN(xb_ld(&bar[XB_XGEN(b.x)]) == gen, bar);
            __builtin_amdgcn_fence(__ATOMIC_ACQUIRE, "agent");
            asm volatile("s_waitcnt vmcnt(0)" ::: "memory");
        }
    }
    __syncthreads();
}

#ifndef GEMM_SP2
#define GEMM_SP2 true
#endif
#ifndef GEMM_ALIGN
#define GEMM_ALIGN true
#endif
struct Ctx { int tid, lane, wid, vcu, G; };

__device__ __forceinline__ void small_gemm_item(LAS unsigned char* lds, const Ctx& X, const float* src, int srcS, bool use_silu, const float* W, int ldw, int ncols, int n0, const float* bias, float* out, int outS) {
    LAS float* SC = (LAS float*)lds;
    __syncthreads();
#pragma unroll
    for (int it = 0; it < 16; ++it) { const int t = X.tid + 512 * it, b = t >> 8, k4 = t & 255; f32x4 v = *(const f32x4*)(src + (size_t)b * srcS + 4 * k4);
        if (use_silu) { v[0] = siluf(v[0]); v[1] = siluf(v[1]); v[2] = siluf(v[2]); v[3] = siluf(v[3]); }
        *(LAS f32x4*)(SC + b * 1024 + 4 * k4) = v; }
    __syncthreads();
    float acc[32];
#pragma unroll
    for (int b = 0; b < 32; ++b) acc[b] = 0.f;
    const int nc = (n0 + X.lane < ncols) ? n0 + X.lane : ncols - 1;
    const float* wp = W + (size_t)(X.wid * 128) * ldw + nc;
#pragma unroll 4
    for (int k = 0; k < 128; k += 4) { const float w0 = wp[(size_t)k * ldw], w1 = wp[(size_t)(k + 1) * ldw], w2 = wp[(size_t)(k + 2) * ldw], w3 = wp[(size_t)(k + 3) * ldw];
#pragma unroll
        for (int b = 0; b < 32; ++b) { const f32x4 s4 = *(const LAS f32x4*)(SC + b * 1024 + X.wid * 128 + k); acc[b] += (s4[0] * w0 + s4[1] * w1) + (s4[2] * w2 + s4[3] * w3); } }
    __syncthreads();
    LAS float* RED = (LAS float*)lds;
#pragma unroll
    for (int b = 0; b < 32; ++b) RED[(X.wid * 32 + b) * 64 + X.lane] = acc[b];
    __syncthreads();
    for (int o = X.tid; o < 2048; o += 512) { const int b = o >> 6, nn = o & 63; float sv = bias ? bias[n0 + nn < ncols ? n0 + nn : ncols - 1] : 0.f;
#pragma unroll
        for (int w = 0; w < 8; ++w) sv += RED[(w * 32 + b) * 64 + nn];
        if (n0 + nn < ncols) out[(size_t)b * outS + n0 + nn] = sv; }
}
__device__ __forceinline__ void mod_phase(LAS unsigned char* lds, const Ctx& X, const float* c, const float* w_ada, const float* b_ada, float* mod) {
    for (int item = X.vcu; item < 192; item += X.G) { const int l = item / 48, n0 = (item % 48) * 64;
        small_gemm_item(lds, X, c, 1024, true, w_ada + (size_t)l * 1024 * 3072, 3072, 3072, n0, b_ada + l * 3072, mod + (size_t)l * 32 * 3072, 3072); }
    __syncthreads();
}
__device__ __forceinline__ void shiftw_phase(LAS unsigned char* lds, const Ctx& X, const float* mod, const float* w_in_a, const float* w_in_c, float* shw) {
    for (int item = X.vcu; item < 170; item += X.G) {
        int l, j; if (item < 36) { l = 0; j = item; } else if (item < 85) { l = 1; j = item - 36; } else if (item < 121) { l = 2; j = item - 85; } else { l = 3; j = item - 121; }
        const bool odd = (l & 1) != 0; const int N = odd ? ODD_IN : EVEN_IN;
        const float* W = odd ? w_in_c + (size_t)(l >> 1) * 1024 * ODD_IN : w_in_a + (size_t)(l >> 1) * 1024 * EVEN_IN;
        small_gemm_item(lds, X, mod + (size_t)l * 32 * 3072, 3072, false, W, N, N, j * 64, nullptr, shw + (size_t)l * 32 * 3328, 3328); }
    __syncthreads();
}

__device__ __forceinline__ void transpose_item(const float* W, int K, int N, bf16_t* WT, LAS float* scr, int item, int lane) {
    const int nblk = N / 32, kb = item / nblk, nb = item % nblk, k0 = 64 * kb, n0 = 32 * nb;
#pragma unroll 8
    for (int i = 0; i < 32; ++i) { const int kk = 2 * i + (lane >> 5); scr[kk * 33 + (lane & 31)] = W[(size_t)(k0 + kk) * N + n0 + (lane & 31)]; }
    asm volatile("s_waitcnt lgkmcnt(0)" ::: "memory");
    const int c = lane & 7;
#pragma unroll
    for (int j = 0; j < 4; ++j) { const int n = (lane >> 3) + 8 * j; const LAS float* s = scr + (8 * c) * 33 + n;
        u32x4 o; o.x = cvt_pk_bf16(s[0 * 33], s[1 * 33]); o.y = cvt_pk_bf16(s[2 * 33], s[3 * 33]); o.z = cvt_pk_bf16(s[4 * 33], s[5 * 33]); o.w = cvt_pk_bf16(s[6 * 33], s[7 * 33]);
        *(u32x4*)(WT + (size_t)(n0 + n) * K + k0 + 8 * c) = o; }
    asm volatile("s_waitcnt lgkmcnt(0)" ::: "memory");
}
struct WPtrs { const float *w_in_a, *w_out_a, *w_in_c, *w_out_c, *w_pool; };
__device__ __forceinline__ void transpose_phase(LAS unsigned char* lds, const Ctx& X, const WPtrs& P, unsigned char* ws) {
    LAS float* scr = (LAS float*)(lds + X.wid * 16384);
    const int gw = X.vcu * 8 + X.wid, NGW = X.G * 8;
    constexpr int I_INA = 16 * 72, I_OUT = 16 * 32, I_INC = 16 * 97, I_POOL = 2 * 4;
    constexpr int NITEMS = 2 * I_INA + 2 * I_OUT + 2 * I_INC + 2 * I_OUT + 8 * I_POOL;
    for (int it = gw; it < NITEMS; it += NGW) {
        int r = it;
        if (r < 2 * I_INA) { const int i = r / I_INA; transpose_item(P.w_in_a + (size_t)i * 1024 * EVEN_IN, 1024, EVEN_IN, (bf16_t*)(ws + WS_WINA) + (size_t)i * EVEN_IN * 1024, scr, r % I_INA, X.lane); continue; } r -= 2 * I_INA;
        if (r < 2 * I_OUT) { const int i = r / I_OUT; transpose_item(P.w_out_a + (size_t)i * 1024 * 1024, 1024, 1024, (bf16_t*)(ws + WS_WOUTA) + (size_t)i * 1024 * 1024, scr, r % I_OUT, X.lane); continue; } r -= 2 * I_OUT;
        if (r < 2 * I_INC) { const int i = r / I_INC; transpose_item(P.w_in_c + (size_t)i * 1024 * ODD_IN, 1024, ODD_IN, (bf16_t*)(ws + WS_WINC) + (size_t)i * ODD_INP * 1024, scr, r % I_INC, X.lane); continue; } r -= 2 * I_INC;
        if (r < 2 * I_OUT) { const int i = r / I_OUT; transpose_item(P.w_out_c + (size_t)i * 1024 * 1024, 1024, 1024, (bf16_t*)(ws + WS_WOUTC) + (size_t)i * 1024 * 1024, scr, r % I_OUT, X.lane); continue; } r -= 2 * I_OUT;
        { const int i = r / I_POOL; transpose_item(P.w_pool + (size_t)i * 16384, 128, 128, (bf16_t*)(ws + WS_WPT) + (size_t)i * 16384, scr, r % I_POOL, X.lane); }
    }
    for (int t = (X.vcu * 512 + X.tid); t < 2 * 224 * 128; t += X.G * 512) { const int i = t / (224 * 128), rr = t % (224 * 128);
        *(u32x4*)((bf16_t*)(ws + WS_WINC) + ((size_t)i * ODD_INP + ODD_IN) * 1024 + (size_t)rr * 8) = (u32x4){0u, 0u, 0u, 0u}; }
}

__device__ __forceinline__ float wave_sum(float v) {
#pragma unroll
    for (int o = 1; o < 64; o <<= 1) v += __shfl_xor(v, o);
    return v;
}
__device__ __forceinline__ void prenorm_phase(const Ctx& X, const float* x, const float* nw, const float* modl, bf16_t* hp, float* rowss) {
    const int gw = X.vcu * 8 + X.wid, NGW = X.G * 8;
#pragma unroll 2
    for (int m = gw; m < MTOK; m += NGW) {
        const int b = m >> 11;
        const f32x4* xr = (const f32x4*)(x + (size_t)m * D) + X.lane;
        f32x4 v[4]; float s = 0.f;
#pragma unroll
        for (int j = 0; j < 4; ++j) { v[j] = xr[64 * j]; s += (v[j][0] * v[j][0] + v[j][1] * v[j][1]) + (v[j][2] * v[j][2] + v[j][3] * v[j][3]); }
        s = wave_sum(s); if (X.lane == 0) rowss[m] = s;
        const f32x4* nwp = (const f32x4*)nw + X.lane; const f32x4* scp = (const f32x4*)(modl + b * 3072 + 1024) + X.lane;
        u32x2* o8 = (u32x2*)(hp + (size_t)m * D) + X.lane;
#pragma unroll
        for (int j = 0; j < 4; ++j) { const f32x4 y = v[j] * nwp[64 * j] * (scp[64 * j] + 1.0f);
            u32x2 o; o.x = cvt_pk_bf16(y[0], y[1]); o.y = cvt_pk_bf16(y[2], y[3]); o8[64 * j] = o; }
    }
}

template <int HW> __device__ __forceinline__ void pool_window(LAS unsigned char* lds, int U_OFF, int P_OFF, int US, int tid, int s0) {
    const int cp = tid & 63, t0 = 16 * (tid >> 6);
    constexpr int NR = 16 + 2 * HW - 1;
    unsigned rw[NR];
#pragma unroll
    for (int k = 0; k < NR; ++k) rw[k] = *(const LAS unsigned*)(lds + U_OFF + (t0 + 8 - HW + k) * US + cp * 4);
    float a0 = 0.f, a1 = 0.f;
#pragma unroll
    for (int k = 0; k < 2 * HW; ++k) { a0 += bflo(rw[k]); a1 += bfhi(rw[k]); }
#pragma unroll
    for (int it = 0; it < 16; ++it) { const int s = s0 + t0 + it;
        if (it > 0) { a0 += bflo(rw[2 * HW - 1 + it]) - bflo(rw[it - 1]); a1 += bfhi(rw[2 * HW - 1 + it]) - bfhi(rw[it - 1]); }
        int lo = s - HW, hi = s + HW - 1; lo = lo < 0 ? 0 : lo; hi = hi > SEQ - 1 ? SEQ - 1 : hi; const float inv = __builtin_amdgcn_rcpf((float)(hi - lo + 1));
        const unsigned uc = rw[HW + it];
        *(LAS unsigned*)(lds + P_OFF + (t0 + it) * US + cp * 4) = cvt_pk_bf16(a0 * inv - bflo(uc), a1 * inv - bfhi(uc)); }
}
__device__ __forceinline__ void pool_phase(LAS unsigned char* lds, const Ctx& X, const bf16_t* proj, const bf16_t* WpT, const float* pscale, bf16_t* mix) {
    constexpr int US = 272, U_OFF = 0, P_OFF = 144 * US, W_OFF = P_OFF + 128 * US;
    const int tid = X.tid, fr = X.lane & 15, fq = X.lane >> 4;
    u32x4 pu[5];
#define POOL_LOADU(item_) do { const int g_ = (item_) >> 9, tt_ = (item_) & 511, row0_ = tt_ * 128, b_ = row0_ >> 11, s0_ = row0_ & 2047; \
        _Pragma("unroll") for (int it = 0; it < 5; ++it) { const int t = tid + 512 * it, rr = t >> 4, pc = t & 15, s = s0_ - 8 + rr; pu[it] = (u32x4){0u, 0u, 0u, 0u}; \
            if (t < 144 * 16 && s >= 0 && s < SEQ) pu[it] = *(const u32x4*)(proj + ((size_t)b_ * SEQ + s) * EVEN_IN + g_ * 128 + pc * 8); } } while (0)
    if (X.vcu < 2048) POOL_LOADU(X.vcu);
    int gprev = -1;
    for (int item = X.vcu; item < 2048; item += X.G) {
        const int g = item >> 9, tt = item & 511, row0 = tt * 128, s0 = row0 & 2047; const bool neww = (g != gprev); gprev = g;
        const size_t tok = (size_t)row0 + 16 * X.wid + fr;
        u32x2 zr[8];
#pragma unroll
        for (int df = 0; df < 8; ++df) zr[df] = *(const u32x2*)(proj + tok * EVEN_IN + 512 + g * 128 + 16 * df + 4 * fq);
        u32x4 wv[4];
#pragma unroll
        for (int it = 0; it < 4; ++it) { const int t = tid + 512 * it, d = t >> 4, pc = t & 15; wv[it] = neww ? *(const u32x4*)(WpT + (size_t)g * 16384 + d * 128 + pc * 8) : (u32x4){0u, 0u, 0u, 0u}; }
        __syncthreads();
#pragma unroll
        for (int it = 0; it < 5; ++it) { const int t = tid + 512 * it, rr = t >> 4, pc = t & 15; if (t < 144 * 16) *(LAS u32x4*)(lds + U_OFF + rr * US + pc * 16) = pu[it]; }
        if (neww) {
#pragma unroll
        for (int it = 0; it < 4; ++it) { const int t = tid + 512 * it, d = t >> 4, pc = t & 15; *(LAS u32x4*)(lds + W_OFF + d * US + pc * 16) = wv[it]; } }
        { const int nxt = item + X.G < 2048 ? item + X.G : item; POOL_LOADU(nxt); }
        __syncthreads();
        if (g == 0) pool_window<1>(lds, U_OFF, P_OFF, US, tid, s0); else if (g == 1) pool_window<2>(lds, U_OFF, P_OFF, US, tid, s0);
        else if (g == 2) pool_window<4>(lds, U_OFF, P_OFF, US, tid, s0); else pool_window<8>(lds, U_OFF, P_OFF, US, tid, s0);
        __syncthreads();
        f32x4 acc[8];
#pragma unroll
        for (int df = 0; df < 8; ++df) acc[df] = (f32x4){0.f, 0.f, 0.f, 0.f};
#pragma unroll
        for (int ks = 0; ks < 4; ++ks) { const bf16x8 pb = *(const LAS bf16x8*)(lds + P_OFF + (16 * X.wid + fr) * US + ks * 64 + fq * 16);
#pragma unroll
            for (int df = 0; df < 8; ++df) { const bf16x8 wa = *(const LAS bf16x8*)(lds + W_OFF + (16 * df + fr) * US + ks * 64 + fq * 16); acc[df] = mfma16(wa, pb, acc[df]); } }
#pragma unroll
        for (int df = 0; df < 8; ++df) { const int c = g * 128 + 16 * df + 4 * fq; const f32x4 ps = *(const f32x4*)(pscale + c); const u32x2 z = zr[df];
            u32x2 o; o.x = cvt_pk_bf16(acc[df][0] * ps[0] * siluf(bflo(z.x)), acc[df][1] * ps[1] * siluf(bfhi(z.x))); o.y = cvt_pk_bf16(acc[df][2] * ps[2] * siluf(bflo(z.y)), acc[df][3] * ps[3] * siluf(bfhi(z.y)));
            *(u32x2*)(mix + tok * 1024 + c) = o; }
    }
#undef POOL_LOADU
    __syncthreads();
}

__device__ __forceinline__ void attn_phase(LAS unsigned char* lds, const Ctx& X, const bf16_t* proj, const bf16_t* VTg, const float* qw, const float* kw, const float* sink, bf16_t* mix) {
    constexpr int KS = 144, VS = 816, V_OFF = 384 * KS;
    const int tid = X.tid, wid = X.wid;
    for (int item = X.vcu; item < 1024; item += X.G) {
        const int kvh = item & 1, qb = (item >> 1) & 15, b = item >> 5, q0 = qb * 128; const size_t rowbase = (size_t)b * SEQ;
        __syncthreads();
        u32x4 kr[6];
#pragma unroll
        for (int it = 0; it < 6; ++it) { const int t = tid + 512 * it, jj = t >> 3, pc = t & 7, kpos = q0 - 128 + jj, kc = kpos < 0 ? 0 : (kpos > SEQ - 1 ? SEQ - 1 : kpos);
            kr[it] = *(const u32x4*)(proj + (rowbase + kc) * EVEN_IN + 1536 + kvh * 64 + pc * 8); }
#pragma unroll
        for (int it = 0; it < 6; ++it) { const int t = tid + 512 * it, jj = t >> 3, pc = t & 7, kpos = q0 - 128 + jj; const bool ok = (kpos >= 0) && (kpos < SEQ);
            u32x4 raw; raw.x = ok ? kr[it].x : 0u; raw.y = ok ? kr[it].y : 0u; raw.z = ok ? kr[it].z : 0u; raw.w = ok ? kr[it].w : 0u;
            float f[8]; f[0] = bflo(raw.x); f[1] = bfhi(raw.x); f[2] = bflo(raw.y); f[3] = bfhi(raw.y); f[4] = bflo(raw.z); f[5] = bfhi(raw.z); f[6] = bflo(raw.w); f[7] = bfhi(raw.w);
            float ss = 0.f;
#pragma unroll
            for (int e = 0; e < 8; ++e) ss += f[e] * f[e];
            ss += __shfl_xor(ss, 1); ss += __shfl_xor(ss, 2); ss += __shfl_xor(ss, 4);
            const float r = __builtin_amdgcn_rsqf(ss * (1.f / 64.f) + 1e-6f);
            const f32x4 w0 = *(const f32x4*)(kw + pc * 8), w1 = *(const f32x4*)(kw + pc * 8 + 4);
            u32x4 o; o.x = cvt_pk_bf16(f[0] * r * w0[0], f[1] * r * w0[1]); o.y = cvt_pk_bf16(f[2] * r * w0[2], f[3] * r * w0[3]); o.z = cvt_pk_bf16(f[4] * r * w1[0], f[5] * r * w1[1]); o.w = cvt_pk_bf16(f[6] * r * w1[2], f[7] * r * w1[3]);
            *(LAS u32x4*)(lds + jj * KS + pc * 16) = o; }
        u32x4 vr[7];
#pragma unroll
        for (int it = 0; it < 7; ++it) { const int t0 = tid + 512 * it, t = t0 < 64 * 50 ? t0 : 64 * 50 - 1, d = t / 50, pc = t % 50, kpos0 = q0 - 128 + pc * 8, kc = kpos0 < 0 ? 0 : (kpos0 > SEQ - 8 ? SEQ - 8 : kpos0);
            vr[it] = *(const u32x4*)(VTg + ((size_t)((b * 2 + kvh) * 64 + d)) * 2048 + kc); }
#pragma unroll
        for (int it = 0; it < 7; ++it) { const int t = tid + 512 * it, d = t / 50, pc = t % 50, jj0 = pc * 8, kpos0 = q0 - 128 + jj0; const bool ok = (jj0 < 384) && (kpos0 >= 0) && (kpos0 < SEQ);
            u32x4 v; v.x = ok ? vr[it].x : 0u; v.y = ok ? vr[it].y : 0u; v.z = ok ? vr[it].z : 0u; v.w = ok ? vr[it].w : 0u;
            if (t < 64 * 50) *(LAS u32x4*)(lds + V_OFF + d * VS + pc * 16) = v; }
        __syncthreads();
        const int hq = kvh * 4 + (wid >> 1), qh = wid & 1;
        const float L2E = 1.4426950408889634f;
        const float slope2 = exp2f(-(float)(hq + 1)) * L2E, sink2 = sink[hq] * L2E;
        u32x4 qr0, qr1; u32x2 zr[4];
#define ATT_LOADQ(qf_) do { int l_ = X.lane; asm volatile("" : "+v"(l_)); const size_t tq_ = rowbase + q0 + (qh * 4 + (qf_)) * 16 + (l_ & 15); \
            const bf16_t* qp_ = proj + tq_ * EVEN_IN + 1024 + hq * 64 + (l_ >> 4) * 8; qr0 = *(const u32x4*)qp_; qr1 = *(const u32x4*)(qp_ + 32); \
            _Pragma("unroll") for (int df = 0; df < 4; ++df) zr[df] = *(const u32x2*)(proj + tq_ * EVEN_IN + 1792 + hq * 64 + 16 * df + 4 * (l_ >> 4)); } while (0)
        ATT_LOADQ(0);
#pragma unroll 1
        for (int qf = 0; qf < 4; ++qf) {
            int ln = X.lane; asm volatile("" : "+v"(ln)); const int fr = ln & 15, fq = ln >> 4;
            const int qfi = qh * 4 + qf, qo = qfi * 16; const size_t tq = rowbase + q0 + qo + fr;
            bf16x8 Q0, Q1; u32x2 zc[4];
            { const u32x4 r0 = qr0, r1 = qr1;
#pragma unroll
              for (int df = 0; df < 4; ++df) zc[df] = zr[df];
              float f[16]; f[0] = bflo(r0.x); f[1] = bfhi(r0.x); f[2] = bflo(r0.y); f[3] = bfhi(r0.y); f[4] = bflo(r0.z); f[5] = bfhi(r0.z); f[6] = bflo(r0.w); f[7] = bfhi(r0.w);
              f[8] = bflo(r1.x); f[9] = bfhi(r1.x); f[10] = bflo(r1.y); f[11] = bfhi(r1.y); f[12] = bflo(r1.z); f[13] = bfhi(r1.z); f[14] = bflo(r1.w); f[15] = bfhi(r1.w);
              float ss = 0.f;
#pragma unroll
              for (int e = 0; e < 16; ++e) ss += f[e] * f[e];
              ss += __shfl_xor(ss, 16); ss += __shfl_xor(ss, 32);
              const float r = (0.125f * L2E) * __builtin_amdgcn_rsqf(ss * (1.f / 64.f) + 1e-6f);
              const f32x4 wa = *(const f32x4*)(qw + fq * 8), wb = *(const f32x4*)(qw + fq * 8 + 4), wc_ = *(const f32x4*)(qw + 32 + fq * 8), wd = *(const f32x4*)(qw + 32 + fq * 8 + 4);
              u32x4 a, c2;
              a.x = cvt_pk_bf16(f[0] * r * wa[0], f[1] * r * wa[1]); a.y = cvt_pk_bf16(f[2] * r * wa[2], f[3] * r * wa[3]); a.z = cvt_pk_bf16(f[4] * r * wb[0], f[5] * r * wb[1]); a.w = cvt_pk_bf16(f[6] * r * wb[2], f[7] * r * wb[3]);
              c2.x = cvt_pk_bf16(f[8] * r * wc_[0], f[9] * r * wc_[1]); c2.y = cvt_pk_bf16(f[10] * r * wc_[2], f[11] * r * wc_[3]); c2.z = cvt_pk_bf16(f[12] * r * wd[0], f[13] * r * wd[1]); c2.w = cvt_pk_bf16(f[14] * r * wd[2], f[15] * r * wd[3]);
              Q0 = as_bf16x8(a); Q1 = as_bf16x8(c2); }
            ATT_LOADQ(qf < 3 ? qf + 1 : 3);
            f32x4 s[17];
#pragma unroll
            for (int kf = 0; kf < 17; ++kf) { const LAS unsigned char* kp = lds + ((qfi + kf) * 16 + fr) * KS + fq * 16;
                f32x4 a = (f32x4){0.f, 0.f, 0.f, 0.f}; a = mfma16(*(const LAS bf16x8*)kp, Q0, a); a = mfma16(*(const LAS bf16x8*)(kp + 64), Q1, a); s[kf] = a; }
            const int posq = q0 + qo + fr; const float tf = (float)(4 * fq - fr);
            const float lo = fmaxf(-128.f, -(float)posq), hi = fminf(128.f, (float)(SEQ - 1 - posq));
            float mx = sink2;
            if (qb == 0 || qb == 15) {
#pragma unroll
                for (int kf = 0; kf < 17; ++kf)
#pragma unroll
                    for (int e = 0; e < 4; ++e) { const float d = tf + (float)(16 * kf + e - 128); const bool valid = (d >= lo) && (d <= hi);
                        const float v = valid ? s[kf][e] - slope2 * fabsf(d) : -1e30f; s[kf][e] = v; mx = fmaxf(mx, v); }
            } else {
#pragma unroll
                for (int kf = 0; kf < 17; ++kf)
#pragma unroll
                    for (int e = 0; e < 4; ++e) { const float d = tf + (float)(16 * kf + e - 128); float v = s[kf][e] - slope2 * fabsf(d);
                        if (kf == 0) v = (d >= -128.f) ? v : -1e30f;
                        if (kf == 16) v = (d <= 128.f) ? v : -1e30f;
                        s[kf][e] = v; mx = fmaxf(mx, v); }
            }
            mx = fmaxf(mx, __shfl_xor(mx, 16)); mx = fmaxf(mx, __shfl_xor(mx, 32));
            float sum = 0.f;
#pragma unroll
            for (int kf = 0; kf < 17; ++kf)
#pragma unroll
                for (int e = 0; e < 4; ++e) { const float p = __builtin_amdgcn_exp2f(s[kf][e] - mx); s[kf][e] = p; sum += p; }
            sum += __shfl_xor(sum, 16); sum += __shfl_xor(sum, 32);
            const float inv = __builtin_amdgcn_rcpf(sum + __builtin_amdgcn_exp2f(sink2 - mx));
            f32x4 o[4];
#pragma unroll
            for (int df = 0; df < 4; ++df) o[df] = (f32x4){0.f, 0.f, 0.f, 0.f};
#pragma unroll
            for (int kp = 0; kp < 9; ++kp) { u32x4 pb; pb.x = cvt_pk_bf16(s[2 * kp][0], s[2 * kp][1]); pb.y = cvt_pk_bf16(s[2 * kp][2], s[2 * kp][3]);
                if (kp < 8) { pb.z = cvt_pk_bf16(s[(2 * kp + 1) % 17][0], s[(2 * kp + 1) % 17][1]); pb.w = cvt_pk_bf16(s[(2 * kp + 1) % 17][2], s[(2 * kp + 1) % 17][3]); } else { pb.z = 0u; pb.w = 0u; }
                const bf16x8 P = as_bf16x8(pb);
#pragma unroll
                for (int df = 0; df < 4; ++df) { const LAS unsigned char* vp = lds + V_OFF + (16 * df + fr) * VS + ((qfi + 2 * kp) * 16 + 4 * fq) * 2;
                    const u32x2 lo2 = *(const LAS u32x2*)vp, hi2 = *(const LAS u32x2*)(vp + 32); u32x4 va; va.x = lo2.x; va.y = lo2.y; va.z = hi2.x; va.w = hi2.y;
                    o[df] = mfma16(as_bf16x8(va), P, o[df]); } }
#pragma unroll
            for (int df = 0; df < 4; ++df) { const int c = hq * 64 + 16 * df + 4 * fq; const u32x2 z = zc[df];
                u32x2 ov; ov.x = cvt_pk_bf16(o[df][0] * inv * siluf(bflo(z.x)), o[df][1] * inv * siluf(bfhi(z.x))); ov.y = cvt_pk_bf16(o[df][2] * inv * siluf(bflo(z.y)), o[df][3] * inv * siluf(bfhi(z.y)));
                *(u32x2*)(mix + tq * 1024 + 512 + c) = ov; }
        }
#undef ATT_LOADQ
    }
    __syncthreads();
}

template <int CTRL> __device__ __forceinline__ float dpp_f32(float v) { return __builtin_bit_cast(float, __builtin_amdgcn_update_dpp(0, __builtin_bit_cast(int, v), CTRL, 0xf, 0xf, false)); }
__device__ __forceinline__ void gla_phase(LAS unsigned char* lds, const Ctx& X, const bf16_t* proj, const float* Wg, const float* bg, bf16_t* OF, bf16_t* OB, float* SST, bool ph2, const float* gw, bf16_t* mix) {
    constexpr int RS = 272, TS = 144;
    constexpr int QA = 0, KA = 64 * RS, QX = 2 * 64 * RS, KXT = 3 * 64 * RS, VT = KXT + 128 * TS, ATT = VT + 256 * TS, DEC = ATT + 64 * TS, AW = DEC + 512, PART = AW + 2048;
    static_assert(PART + 2048 <= 147392, "gla lds");
    const int wid = X.wid;
    const float sc = 0.08838834764831845f;
    for (int item = X.vcu; item < 256; item += X.G) {
        const int half = item & 1, hd = (item >> 1) & 3, b = item >> 3, dir = ph2 ? 1 - half : half;
        bf16_t* obuf = dir ? OB : OF; const bf16_t* other = dir ? OF : OB;
        float* sst = SST + ((size_t)((b * 4 + hd) * 2 + dir)) * 32768 + (size_t)wid * 4096;
#define CHUNK(n_) (ph2 ? (dir ? 15 - (n_) : 16 + (n_)) : (dir ? 31 - (n_) : (n_)))
        __syncthreads();
        bf16x8 WgA;
        { const int fr_ = X.lane & 15, fq_ = X.lane >> 4; float wv[8];
#pragma unroll
          for (int j = 0; j < 8; ++j) wv[j] = (fq_ < 2) ? Wg[(size_t)(dir * 16 + 8 * (fq_ & 1) + j) * 512 + hd * 128 + 16 * wid + fr_] : 0.f;
          u32x4 p; p.x = cvt_pk_bf16(wv[0], wv[1]); p.y = cvt_pk_bf16(wv[2], wv[3]); p.z = cvt_pk_bf16(wv[4], wv[5]); p.w = cvt_pk_bf16(wv[6], wv[7]); WgA = as_bf16x8(p); }
        const f32x4 bgv = *(const f32x4*)(bg + dir * 512 + hd * 128 + 16 * wid + 4 * (X.lane >> 4));
        f32x4 S[8][2];
#pragma unroll
        for (int kf = 0; kf < 8; ++kf)
#pragma unroll
            for (int vf = 0; vf < 2; ++vf) S[kf][vf] = ph2 ? *(const f32x4*)(sst + ((kf * 2 + vf) * 64 + X.lane) * 4) : (f32x4){0.f, 0.f, 0.f, 0.f};
        u32x4 pa1 = (u32x4){0u, 0u, 0u, 0u}, raq[2], rak[2]; u32x2 pv[2][4];
#define TOKC(cc, i) ((size_t)b * SEQ + (size_t)(cc) * 64 + (size_t)(dir ? 63 - (i) : (i)))
#define GLA_LOADS(cc) do { int tl = X.tid; asm volatile("" : "+v"(tl)); const int l_ = tl & 63, rbl_ = l_ & 3, cql_ = l_ >> 2; \
            if (tl < 128) pa1 = *(const u32x4*)(proj + TOKC(cc, tl >> 1) * ODD_IN + 3072 + dir * 16 + (tl & 1) * 8); \
            _Pragma("unroll") for (int t = 0; t < 2; ++t) { const int pi = tl + 512 * t; const bf16_t* pp = proj + TOKC(cc, pi >> 4) * ODD_IN + hd * 128 + (pi & 15) * 8; raq[t] = *(const u32x4*)pp; rak[t] = *(const u32x4*)(pp + 512); } \
            _Pragma("unroll") for (int p = 0; p < 2; ++p) { const int ps = 2 * wid + p, rbg = ps >> 2, cg = ps & 3; \
                _Pragma("unroll") for (int r = 0; r < 4; ++r) pv[p][r] = *(const u32x2*)(proj + TOKC(cc, 4 * (4 * rbg + rbl_) + r) * ODD_IN + 1024 + hd * 256 + 4 * (16 * cg + cql_)); } } while (0)
#define GLA_STAGE_A() do { int tl = X.tid; asm volatile("" : "+v"(tl)); if (tl < 128) *(LAS u32x4*)(lds + AW + (tl >> 1) * 32 + (tl & 1) * 16) = pa1; } while (0)
#define GLA_STAGE_QK() do { int tl = X.tid; asm volatile("" : "+v"(tl)); _Pragma("unroll") for (int t = 0; t < 2; ++t) { const int pi = tl + 512 * t; \
            *(LAS u32x4*)(lds + QA + (pi >> 4) * RS + (pi & 15) * 16) = raq[t]; *(LAS u32x4*)(lds + KA + (pi >> 4) * RS + (pi & 15) * 16) = rak[t]; } } while (0)
        GLA_LOADS(CHUNK(0));
        GLA_STAGE_A(); GLA_STAGE_QK();
        __syncthreads();
#pragma unroll 1
        for (int n = 0; n < 16; ++n) {
            const int c = CHUNK(n); const int nn = n < 15 ? n + 1 : 15, cnx = CHUNK(nn);
            int tid = X.tid; asm volatile("" : "+v"(tid)); const int lane = tid & 63, fr = lane & 15, fq = lane >> 4, rb = fr, cs = fq;
            u32x2 pq[4], pk[4];
#pragma unroll
            for (int r = 0; r < 4; ++r) { const int ro = (4 * rb + r) * RS + (16 * wid + 4 * cs) * 2; pq[r] = *(const LAS u32x2*)(lds + QA + ro); pk[r] = *(const LAS u32x2*)(lds + KA + ro); }
            { const int rbl = lane & 3, cql = lane >> 2;
#pragma unroll
              for (int p = 0; p < 2; ++p) { const int ps = 2 * wid + p, rbg = ps >> 2, cg = ps & 3; LAS unsigned char* vp = lds + VT + (4 * (16 * cg + cql)) * TS + (4 * (4 * rbg + rbl)) * 2;
                  u32x2 w;
                  w.x = (pv[p][0].x & 0xffffu) | (pv[p][1].x << 16); w.y = (pv[p][2].x & 0xffffu) | (pv[p][3].x << 16); *(LAS u32x2*)(vp) = w;
                  w.x = (pv[p][0].x >> 16) | (pv[p][1].x & 0xffff0000u); w.y = (pv[p][2].x >> 16) | (pv[p][3].x & 0xffff0000u); *(LAS u32x2*)(vp + TS) = w;
                  w.x = (pv[p][0].y & 0xffffu) | (pv[p][1].y << 16); w.y = (pv[p][2].y & 0xffffu) | (pv[p][3].y << 16); *(LAS u32x2*)(vp + 2 * TS) = w;
                  w.x = (pv[p][0].y >> 16) | (pv[p][1].y & 0xffff0000u); w.y = (pv[p][2].y >> 16) | (pv[p][3].y & 0xffff0000u); *(LAS u32x2*)(vp + 3 * TS) = w; } }
            GLA_LOADS(cnx);
            float x[4][4];
#pragma unroll
            for (int t = 0; t < 4; ++t) { u32x4 av = *(const LAS u32x4*)(lds + AW + (4 * rb + t) * 32 + (fq & 1) * 16); if (fq >= 2) av = (u32x4){0u, 0u, 0u, 0u};
                const f32x4 xa = mfma16(WgA, as_bf16x8(av), bgv);
                x[t][0] = xa[0]; x[t][1] = xa[1]; x[t][2] = xa[2]; x[t][3] = xa[3]; }
            float tot[4], inc[4];
#pragma unroll
            for (int cc = 0; cc < 4; ++cc) { float run = 0.f;
#pragma unroll
                for (int r = 0; r < 4; ++r) { const float xv = x[r][cc]; run += (fminf(xv, 0.f) * 1.4426950408889634f - __builtin_amdgcn_logf(1.0f + __builtin_amdgcn_exp2f(-1.4426950408889634f * fabsf(xv)))) * 0.0625f; x[r][cc] = run; }
                tot[cc] = run; inc[cc] = run; }
#pragma unroll
            for (int cc = 0; cc < 4; ++cc) { inc[cc] += dpp_f32<0x111>(inc[cc]); inc[cc] += dpp_f32<0x112>(inc[cc]); inc[cc] += dpp_f32<0x114>(inc[cc]); inc[cc] += dpp_f32<0x118>(inc[cc]); }
            float blast[4], ref[4];
#pragma unroll
            for (int cc = 0; cc < 4; ++cc) { const float ex = inc[cc] - tot[cc];
#pragma unroll
                for (int r = 0; r < 4; ++r) x[r][cc] += ex;
                blast[cc] = __shfl(inc[cc], (lane & 48) | 15); ref[cc] = __shfl(x[0][cc], (lane & 48) | 8); }
            { float kx[4][4], eref[4], elr[4];
#pragma unroll
              for (int cc = 0; cc < 4; ++cc) { eref[cc] = __builtin_amdgcn_exp2f(ref[cc]); elr[cc] = __builtin_amdgcn_exp2f(blast[cc] - ref[cc]); }
#pragma unroll
              for (int r = 0; r < 4; ++r) { const float q4[4] = {bflo(pq[r].x) * sc, bfhi(pq[r].x) * sc, bflo(pq[r].y) * sc, bfhi(pq[r].y) * sc}; const float k4[4] = {bflo(pk[r].x), bfhi(pk[r].x), bflo(pk[r].y), bfhi(pk[r].y)};
                  float qa[4], ka[4], qx[4];
#pragma unroll
                  for (int cc = 0; cc < 4; ++cc) { const float e1 = __builtin_amdgcn_exp2f(x[r][cc] - ref[cc]), e2 = __builtin_amdgcn_rcpf(e1); qa[cc] = q4[cc] * e1; ka[cc] = k4[cc] * e2; qx[cc] = qa[cc] * eref[cc]; kx[r][cc] = ka[cc] * elr[cc]; }
                  const int ro = (4 * rb + r) * RS + (16 * wid + 4 * cs) * 2;
                  u32x2 w; w.x = cvt_pk_bf16(qa[0], qa[1]); w.y = cvt_pk_bf16(qa[2], qa[3]); *(LAS u32x2*)(lds + QA + ro) = w;
                  w.x = cvt_pk_bf16(ka[0], ka[1]); w.y = cvt_pk_bf16(ka[2], ka[3]); *(LAS u32x2*)(lds + KA + ro) = w;
                  w.x = cvt_pk_bf16(qx[0], qx[1]); w.y = cvt_pk_bf16(qx[2], qx[3]); *(LAS u32x2*)(lds + QX + ro) = w; }
#pragma unroll
              for (int cc = 0; cc < 4; ++cc) { u32x2 w; w.x = cvt_pk_bf16(kx[0][cc], kx[1][cc]); w.y = cvt_pk_bf16(kx[2][cc], kx[3][cc]);
                  *(LAS u32x2*)(lds + KXT + (16 * wid + 4 * cs + cc) * TS + (4 * rb) * 2) = w; }
              if (rb == 0) *(LAS f32x4*)(lds + DEC + (16 * wid + 4 * cs) * 4) = (f32x4){__builtin_amdgcn_exp2f(blast[0]), __builtin_amdgcn_exp2f(blast[1]), __builtin_amdgcn_exp2f(blast[2]), __builtin_amdgcn_exp2f(blast[3])}; }
            __syncthreads();
            u32x2 ov[4][2];
            if (ph2) {
#pragma unroll
                for (int fi = 0; fi < 4; ++fi) { const size_t tk = TOKC(c, 16 * fi + fr);
#pragma unroll
                    for (int vf = 0; vf < 2; ++vf) ov[fi][vf] = *(const u32x2*)(other + tk * 1024 + hd * 256 + 32 * wid + 4 * fq + 16 * vf); } }
            { const int fi = wid >> 1, fj0 = 2 * (wid & 1); f32x4 a0 = (f32x4){0.f, 0.f, 0.f, 0.f}, a1 = (f32x4){0.f, 0.f, 0.f, 0.f};
#pragma unroll
              for (int ks = 0; ks < 4; ++ks) { const bf16x8 qf_ = *(const LAS bf16x8*)(lds + QA + (16 * fi + fr) * RS + ks * 64 + fq * 16);
                  if (fj0 <= fi) a0 = mfma16(qf_, *(const LAS bf16x8*)(lds + KA + (16 * fj0 + fr) * RS + ks * 64 + fq * 16), a0);
                  if (fj0 + 1 <= fi) a1 = mfma16(qf_, *(const LAS bf16x8*)(lds + KA + (16 * (fj0 + 1) + fr) * RS + ks * 64 + fq * 16), a1); }
#pragma unroll
              for (int e = 0; e < 4; ++e) { const int i = 16 * fi + 4 * fq + e, j0 = 16 * fj0 + fr, j1 = j0 + 16; const bool k0 = dir ? (j0 < i) : (j0 <= i), k1 = dir ? (j1 < i) : (j1 <= i);
                  *(LAS unsigned short*)(lds + ATT + i * TS + j0 * 2) = f2bf1(k0 ? a0[e] : 0.f); *(LAS unsigned short*)(lds + ATT + i * TS + j1 * 2) = f2bf1(k1 ? a1[e] : 0.f); } }
            bf16x8 vb[2][2];
#pragma unroll
            for (int vf = 0; vf < 2; ++vf)
#pragma unroll
                for (int ks = 0; ks < 2; ++ks) vb[vf][ks] = *(const LAS bf16x8*)(lds + VT + (32 * wid + 16 * vf + fr) * TS + ks * 64 + fq * 16);
            f32x4 o[4][2];
#pragma unroll
            for (int fi = 0; fi < 4; ++fi) { o[fi][0] = (f32x4){0.f, 0.f, 0.f, 0.f}; o[fi][1] = (f32x4){0.f, 0.f, 0.f, 0.f}; }
#pragma unroll
            for (int a4 = 0; a4 < 4; ++a4) { bf16x8 sb[2];
#pragma unroll
                for (int vf = 0; vf < 2; ++vf) { u32x4 p; p.x = cvt_pk_bf16(S[2 * a4][vf][0], S[2 * a4][vf][1]); p.y = cvt_pk_bf16(S[2 * a4][vf][2], S[2 * a4][vf][3]); p.z = cvt_pk_bf16(S[2 * a4 + 1][vf][0], S[2 * a4 + 1][vf][1]); p.w = cvt_pk_bf16(S[2 * a4 + 1][vf][2], S[2 * a4 + 1][vf][3]); sb[vf] = as_bf16x8(p); }
#pragma unroll
                for (int fi = 0; fi < 4; ++fi) { const LAS unsigned char* qp = lds + QX + (16 * fi + fr) * RS + (32 * a4 + 4 * fq) * 2; const u32x2 lo = *(const LAS u32x2*)qp, hi = *(const LAS u32x2*)(qp + 32);
                    u32x4 qa; qa.x = lo.x; qa.y = lo.y; qa.z = hi.x; qa.w = hi.y; const bf16x8 Bq = as_bf16x8(qa); o[fi][0] = mfma16(sb[0], Bq, o[fi][0]); o[fi][1] = mfma16(sb[1], Bq, o[fi][1]); } }
#pragma unroll
            for (int kf = 0; kf < 8; ++kf) { const f32x4 d4 = *(const LAS f32x4*)((const LAS float*)(lds + DEC) + 16 * kf + 4 * fq); S[kf][0] *= d4; S[kf][1] *= d4; }
#pragma unroll
            for (int ks = 0; ks < 2; ++ks)
#pragma unroll
                for (int kf = 0; kf < 8; ++kf) { const bf16x8 a = *(const LAS bf16x8*)(lds + KXT + (16 * kf + fr) * TS + ks * 64 + fq * 16); S[kf][0] = mfma16(a, vb[0][ks], S[kf][0]); S[kf][1] = mfma16(a, vb[1][ks], S[kf][1]); }
            GLA_STAGE_A();
            __syncthreads();
#pragma unroll
            for (int ks = 0; ks < 2; ++ks)
#pragma unroll
                for (int fi = 0; fi < 4; ++fi) { const bf16x8 a = *(const LAS bf16x8*)(lds + ATT + (16 * fi + fr) * TS + ks * 64 + fq * 16); o[fi][0] = mfma16(vb[0][ks], a, o[fi][0]); o[fi][1] = mfma16(vb[1][ks], a, o[fi][1]); }
            u32x2 zv[4][2];
            if (!ph2) {
#pragma unroll
                for (int fi = 0; fi < 4; ++fi) { bf16_t* op = obuf + TOKC(c, 16 * fi + fr) * 1024 + hd * 256 + 32 * wid + 4 * fq;
#pragma unroll
                    for (int vf = 0; vf < 2; ++vf) { u32x2 w; w.x = cvt_pk_bf16(o[fi][vf][0], o[fi][vf][1]); w.y = cvt_pk_bf16(o[fi][vf][2], o[fi][vf][3]); *(u32x2*)(op + 16 * vf) = w; } }
            } else {
#pragma unroll
                for (int fi = 0; fi < 4; ++fi) { const size_t tk = TOKC(c, 16 * fi + fr);
#pragma unroll
                    for (int vf = 0; vf < 2; ++vf) zv[fi][vf] = *(const u32x2*)(proj + tk * ODD_IN + 2048 + hd * 256 + 32 * wid + 4 * fq + 16 * vf); }
#pragma unroll
                for (int fi = 0; fi < 4; ++fi) { float ss = 0.f;
#pragma unroll
                    for (int vf = 0; vf < 2; ++vf) { o[fi][vf][0] += bflo(ov[fi][vf].x); o[fi][vf][1] += bfhi(ov[fi][vf].x); o[fi][vf][2] += bflo(ov[fi][vf].y); o[fi][vf][3] += bfhi(ov[fi][vf].y);
                        ss += (o[fi][vf][0] * o[fi][vf][0] + o[fi][vf][1] * o[fi][vf][1]) + (o[fi][vf][2] * o[fi][vf][2] + o[fi][vf][3] * o[fi][vf][3]); }
                    ss += __shfl_xor(ss, 16); ss += __shfl_xor(ss, 32);
                    if (fq == 0) ((LAS float*)(lds + PART))[wid * 64 + 16 * fi + fr] = ss; }
            }
            GLA_STAGE_QK();
            __syncthreads();
            if (ph2) {
                const f32x4 gw0 = *(const f32x4*)(gw + 32 * wid + 4 * fq), gw1 = *(const f32x4*)(gw + 32 * wid + 16 + 4 * fq);
#pragma unroll
                for (int fi = 0; fi < 4; ++fi) { float tot = 0.f;
#pragma unroll
                    for (int w = 0; w < 8; ++w) tot += ((const LAS float*)(lds + PART))[w * 64 + 16 * fi + fr];
                    const float r = __builtin_amdgcn_rsqf(tot * (1.f / 256.f) + 1e-6f);
                    bf16_t* mp = mix + TOKC(c, 16 * fi + fr) * 1024 + hd * 256 + 32 * wid + 4 * fq;
#pragma unroll
                    for (int vf = 0; vf < 2; ++vf) { const f32x4 gv = vf ? gw1 : gw0; const u32x2 z = zv[fi][vf];
                        u32x2 w; w.x = cvt_pk_bf16(o[fi][vf][0] * r * gv[0] * siluf(bflo(z.x)), o[fi][vf][1] * r * gv[1] * siluf(bfhi(z.x))); w.y = cvt_pk_bf16(o[fi][vf][2] * r * gv[2] * siluf(bflo(z.y)), o[fi][vf][3] * r * gv[3] * siluf(bfhi(z.y)));
                        *(u32x2*)(mp + 16 * vf) = w; } }
                        }
        }
        if (!ph2) {
#pragma unroll
            for (int kf = 0; kf < 8; ++kf)
#pragma unroll
                for (int vf = 0; vf < 2; ++vf) *(f32x4*)(sst + ((kf * 2 + vf) * 64 + X.lane) * 4) = S[kf][vf]; }
#undef CHUNK
#undef GLA_STAGE_A
#undef GLA_STAGE_QK
#undef GLA_LOADS
#undef TOKC
    }
}
__device__ __forceinline__ void gla_finish_phase(const Ctx& X, const bf16_t* OF, const bf16_t* OB, const bf16_t* proj, const float* gw, bf16_t* mix) {
    const int gwv = X.vcu * 8 + X.wid, NGW = X.G * 8, col0 = X.lane * 16;
    f32x4 w4[4];
#pragma unroll
    for (int q = 0; q < 4; ++q) w4[q] = *(const f32x4*)(gw + (col0 & 255) + 4 * q);
#pragma unroll 2
    for (int m = gwv; m < MTOK; m += NGW) {
        const u32x4* pf = (const u32x4*)(OF + (size_t)m * 1024 + col0); const u32x4* pb = (const u32x4*)(OB + (size_t)m * 1024 + col0); const u32x4* pz = (const u32x4*)(proj + (size_t)m * ODD_IN + 2048 + col0);
        float v[16], z[16]; float ss = 0.f;
#pragma unroll
        for (int h = 0; h < 2; ++h) { const u32x4 a = pf[h], c = pb[h], zz = pz[h];
            v[8 * h + 0] = bflo(a.x) + bflo(c.x); v[8 * h + 1] = bfhi(a.x) + bfhi(c.x); v[8 * h + 2] = bflo(a.y) + bflo(c.y); v[8 * h + 3] = bfhi(a.y) + bfhi(c.y);
            v[8 * h + 4] = bflo(a.z) + bflo(c.z); v[8 * h + 5] = bfhi(a.z) + bfhi(c.z); v[8 * h + 6] = bflo(a.w) + bflo(c.w); v[8 * h + 7] = bfhi(a.w) + bfhi(c.w);
            z[8 * h + 0] = bflo(zz.x); z[8 * h + 1] = bfhi(zz.x); z[8 * h + 2] = bflo(zz.y); z[8 * h + 3] = bfhi(zz.y); z[8 * h + 4] = bflo(zz.z); z[8 * h + 5] = bfhi(zz.z); z[8 * h + 6] = bflo(zz.w); z[8 * h + 7] = bfhi(zz.w); }
#pragma unroll
        for (int e = 0; e < 16; ++e) ss += v[e] * v[e];
        ss += __shfl_xor(ss, 1); ss += __shfl_xor(ss, 2); ss += __shfl_xor(ss, 4); ss += __shfl_xor(ss, 8);
        const float r = 1.0f / sqrtf(ss * (1.f / 256.f) + 1e-6f);
        float y[16];
#pragma unroll
        for (int e = 0; e < 16; ++e) y[e] = v[e] * r * w4[e >> 2][e & 3] * siluf(z[e]);
        u32x4 o0, o1; o0.x = cvt_pk_bf16(y[0], y[1]); o0.y = cvt_pk_bf16(y[2], y[3]); o0.z = cvt_pk_bf16(y[4], y[5]); o0.w = cvt_pk_bf16(y[6], y[7]);
        o1.x = cvt_pk_bf16(y[8], y[9]); o1.y = cvt_pk_bf16(y[10], y[11]); o1.z = cvt_pk_bf16(y[12], y[13]); o1.w = cvt_pk_bf16(y[14], y[15]);
        u32x4* po = (u32x4*)(mix + (size_t)m * 1024 + col0); po[0] = o0; po[1] = o1;
    }
}

struct Args { const float* in[17]; float* out; unsigned char* ws; int ph_lo, ph_hi; };
constexpr int N_PHASES = 2 + 6 * DEPTH;
__global__ void __launch_bounds__(512, 2) fwd_mega(Args args) {
    extern __shared__ __attribute__((aligned(16))) unsigned char lds_raw[];
    LAS unsigned char* lds = (LAS unsigned char*)lds_raw;
    cg::grid_group grid = cg::this_grid();
    Ctx X; X.tid = threadIdx.x; X.lane = X.tid & 63; X.wid = __builtin_amdgcn_readfirstlane(X.tid >> 6); X.G = gridDim.x;
    { const int bx = blockIdx.x; X.vcu = (X.G % 8 == 0) ? (bx % 8) * (X.G / 8) + bx / 8 : bx; }
    const float* x_in = args.in[0]; const float* c_in = args.in[1]; const float* norm_w = args.in[2]; const float* w_ada = args.in[3]; const float* b_ada = args.in[4];
    const float* pool_scale = args.in[7]; const float* q_norm_w = args.in[8]; const float* k_norm_w = args.in[9]; const float* attn_sink = args.in[10];
    const float* w_gate_up = args.in[13]; const float* b_gate = args.in[14]; const float* gla_norm_w = args.in[15];
    unsigned char* ws = args.ws; float* out = args.out;
    float* mod = (float*)(ws + WS_MOD); bf16_t* H = (bf16_t*)(ws + WS_H); bf16_t* PROJ = (bf16_t*)(ws + WS_PROJ); bf16_t* VTg = (bf16_t*)(ws + WS_VT); bf16_t* OF = (bf16_t*)(ws + WS_OF); bf16_t* OB = (bf16_t*)(ws + WS_OB);
    bf16_t* HP = (bf16_t*)(ws + WS_HP); float* ROWSS = (float*)(ws + WS_ROWSS); float* SHW = (float*)(ws + WS_SHW);
    const int lo = args.ph_lo, hi = args.ph_hi;
    if (threadIdx.x < 16) ((LAS unsigned*)(lds + LDS_MISC))[threadIdx.x] = 0u;
    __syncthreads();
    XcdBarrier bar = xcd_barrier_post((unsigned*)(ws + WS_BAR), (volatile LAS unsigned*)(lds + LDS_MISC));
    const bool one = (hi - lo) > 1;
#define IN(k) (lo <= (k) && (k) < hi)
#define FRESH(Y) Ctx Y = X; asm volatile("" : "+v"(Y.tid), "+v"(Y.lane))
#define SEAM(k) do { if (one && IN((k) + 1)) xcd_barrier(bar); } while (0)
    if (hi < 0) grid.sync();
    if (IN(0)) { FRESH(Y); mod_phase(lds, Y, c_in, w_ada, b_ada, mod); SEAM(0); }
    if (IN(1)) { WPtrs P{args.in[5], args.in[11], args.in[12], args.in[16], args.in[6]}; FRESH(Y); shiftw_phase(lds, Y, mod, args.in[5], args.in[12], SHW); transpose_phase(lds, Y, P, ws); __syncthreads();
        prenorm_phase(Y, x_in, norm_w, mod, HP, ROWSS); SEAM(1); }
#pragma unroll 1
    for (int l = 0; l < DEPTH; ++l) {
        const int pb = 2 + 6 * l, i2 = l >> 1; const bool odd = (l & 1) != 0;
        const float* xsrc = (l == 0) ? x_in : out; const float* modl = mod + (size_t)l * 32 * 3072;
        if (IN(pb + 1)) {
            const bf16_t* Ap = HP; const bf16_t* Bp = (const bf16_t*)(ws + (odd ? WS_WINC : WS_WINA)) + (size_t)i2 * (odd ? ODD_INP : EVEN_IN) * 1024; asm volatile("" : "+s"(Ap), "+s"(Bp));
            if (!odd) { pg8::Gemm g{Ap, Bp, MTOK, EVEN_IN, D}; pg8::StaticOrder S; S.init(MTOK, EVEN_IN, X.G, (int)blockIdx.x);
                pg8::EpiProj E{PROJ, EVEN_IN, EVEN_IN, VTg, ROWSS + (size_t)l * MTOK, SHW + (size_t)l * 32 * 3328}; pg8::gemm_phase<pg8::EpiProj, pg8::StaticOrder, GEMM_ALIGN, GEMM_SP2>(lds, g, S, E); }
            else { pg8::Gemm g{Ap, Bp, MTOK, ODD_INP, D}; pg8::StaticOrder S; S.init(MTOK, ODD_INP, X.G, (int)blockIdx.x);
                pg8::EpiProj E{PROJ, ODD_IN, ODD_IN, nullptr, ROWSS + (size_t)l * MTOK, SHW + (size_t)l * 32 * 3328}; pg8::gemm_phase<pg8::EpiProj, pg8::StaticOrder, GEMM_ALIGN, GEMM_SP2>(lds, g, S, E); }
            SEAM(pb + 1);
        }
        if (IN(pb + 2)) {
#ifdef DUP_MIX
            for (int rep = 0; rep < 2; ++rep) {
#endif
            FRESH(Y); if (!odd) { pool_phase(lds, Y, PROJ, (const bf16_t*)(ws + WS_WPT) + (size_t)i2 * 4 * 16384, pool_scale + i2 * 512, H);
                attn_phase(lds, Y, PROJ, VTg, q_norm_w + i2 * 64, k_norm_w + i2 * 64, attn_sink + i2 * 8, H); }
            else gla_phase(lds, Y, PROJ, w_gate_up + (size_t)i2 * 2 * 16 * 512, b_gate + i2 * 2 * 512, OF, OB, (float*)(ws + WS_SST), false, gla_norm_w + i2 * 256, H);
#ifdef DUP_MIX
            }
#endif
            SEAM(pb + 2);
        }
        if (IN(pb + 3)) { FRESH(Y); if (odd) gla_phase(lds, Y, PROJ, w_gate_up + (size_t)i2 * 2 * 16 * 512, b_gate + i2 * 2 * 512, OF, OB, (float*)(ws + WS_SST), true, gla_norm_w + i2 * 256, H); if (odd) SEAM(pb + 3); }
        if (IN(pb + 4)) {
            const bf16_t* Ap = H; const bf16_t* Bp = (const bf16_t*)(ws + (odd ? WS_WOUTC : WS_WOUTA)) + (size_t)i2 * 1024 * 1024; asm volatile("" : "+s"(Ap), "+s"(Bp));
            pg8::Gemm g{Ap, Bp, MTOK, D, D}; pg8::StaticOrder S; S.init(MTOK, D, X.G, (int)blockIdx.x);
            pg8::EpiOut E{xsrc, out, modl + 2048, (l + 1 < DEPTH) ? HP : nullptr, norm_w + (l + 1) * 1024, modl + 32 * 3072 + 1024, ROWSS + (size_t)(l + 1) * MTOK}; pg8::gemm_phase<pg8::EpiOut, pg8::StaticOrder, GEMM_ALIGN, GEMM_SP2>(lds, g, S, E);
            if (l + 1 < DEPTH) { if (one && IN(pb + 6)) xcd_barrier(bar); }
        }
    }
#undef IN
#undef SEAM
}

#ifndef MK_ONE_LAUNCH
#define MK_ONE_LAUNCH 1
#endif
extern "C" void kernel_launch(void* const* d_in, const int* in_sizes, int n_in, void* d_out, int out_size, void* d_ws, size_t ws_size, hipStream_t stream) {
    static int grid = 0;
    if (grid == 0) {
        int dev = 0, cus = 0, per_cu = 0;
        if (hipGetDevice(&dev) != hipSuccess || hipDeviceGetAttribute(&cus, hipDeviceAttributeMultiprocessorCount, dev) != hipSuccess) { fprintf(stderr, "kernel_launch: device query failed\n"); grid = -1; return; }
        if (hipFuncSetAttribute((const void*)fwd_mega, hipFuncAttributeMaxDynamicSharedMemorySize, LDS_BYTES) != hipSuccess) { fprintf(stderr, "kernel_launch: hipFuncSetAttribute failed\n"); grid = -1; return; }
        if (hipOccupancyMaxActiveBlocksPerMultiprocessor(&per_cu, (const void*)fwd_mega, 512, LDS_BYTES) != hipSuccess || per_cu < 1) fprintf(stderr, "kernel_launch: occupancy query reports %d\n", per_cu);
        (void)hipGetLastError();
        if (n_in != 17 || out_size != MTOK * D || ws_size < WS_END) { fprintf(stderr, "kernel_launch: unexpected shapes (n_in %d out %d ws %zu)\n", n_in, out_size, ws_size); grid = -1; return; }
        grid = cus;
    }
    if (grid < 0) return;
    if (hipMemsetAsync((unsigned char*)d_ws + WS_BAR, 0, 16384, stream) != hipSuccess) fprintf(stderr, "kernel_launch: memset failed\n");
    if (hipMemsetAsync((unsigned char*)d_ws + WS_ROWSS, 0, 4 * MTOK * sizeof(float), stream) != hipSuccess) fprintf(stderr, "kernel_launch: memset failed\n");
    Args a{};
    for (int i = 0; i < 17; ++i) a.in[i] = (const float*)d_in[i];
    a.out = (float*)d_out; a.ws = (unsigned char*)d_ws;
#if MK_ONE_LAUNCH
    a.ph_lo = 0; a.ph_hi = N_PHASES;
    void* kargs[] = {&a};
    hipError_t e = hipLaunchCooperativeKernel((void*)fwd_mega, dim3(grid), dim3(512), kargs, LDS_BYTES, stream);
    if (e != hipSuccess) fprintf(stderr, "kernel_launch: cooperative launch failed: %s (grid %d)\n", hipGetErrorString(e), grid);
#else
    for (int p = 0; p < N_PHASES; ++p) { const int q = (p - 2) % 6; if (p >= 2 && (q == 5 || q == 0 || (q == 3 && (((p - 2) / 6) & 1) == 0))) continue;
        a.ph_lo = p; a.ph_hi = p + 1; void* kargs[] = {&a};
        hipError_t e = hipLaunchCooperativeKernel((void*)fwd_mega, dim3(grid), dim3(512), kargs, LDS_BYTES, stream);
        if (e != hipSuccess) { fprintf(stderr, "kernel_launch: launch of phase %d failed: %s\n", p, hipGetErrorString(e)); break; } }
#endif
}
```

```cpp
#include <hip/hip_runtime.h>
#include <hip/hip_cooperative_groups.h>
#include <cstdio>
namespace cg = cooperative_groups;

namespace pg8 {
#define PG8_LAS __attribute__((address_space(3)))
typedef unsigned short bf16_t;
typedef short bf16x8 __attribute__((ext_vector_type(8)));
typedef float f32x4 __attribute__((ext_vector_type(4)));
typedef unsigned u32x4 __attribute__((ext_vector_type(4)));
typedef unsigned u32x2 __attribute__((ext_vector_type(2)));
constexpr int BM = 256, BK = 64, HALF = 128, HTB = HALF * BK * 2  , STAGE_BYTES = 8 * HTB, NXCD = 8, WGM = 8;

__host__ __device__ __forceinline__ int lds_byte(int r, int c) { const int st = (r >> 4) * 2 + (c >> 5), rr = r & 15, cc = c & 31, ob = rr * 64 + cc * 2; return st * 1024 + (ob ^ (((ob >> 9) & 1) << 5)); }
__host__ __device__ __forceinline__ void stage_rc(int b, int& R, int& C) { const int st = b / 1024, sb = b % 1024, swz = sb ^ (((sb >> 9) & 1) << 5); R = (st >> 1) * 16 + swz / 64; C = (st & 1) * 32 + (swz % 64) / 2; }
__host__ __device__ __forceinline__ int perm32(int rho) { const int n = rho >> 4, i = rho & 15; return 8 * (i >> 2) + 4 * n + (i & 3); }

struct Unit { int pm, pn; };
struct Gemm { const bf16_t* A; const bf16_t* Bt; int M, N, K; };

struct StaticOrder {
    int nM, nN, nwg, G, c;
    __host__ __device__ void init(int M, int N, int G_, int c_) { nM = M / BM; nN = N / BM; nwg = nM * nN; G = G_; c = c_; }
    __host__ __device__ bool next(int i, Unit& u) const {
        const long L = (long)i * G + c; if (L >= nwg) return false;
        int wgid = (int)L; { const int q = nwg / NXCD, r = nwg % NXCD, xcd = wgid % NXCD, off = wgid / NXCD; wgid = (xcd < r ? xcd * (q + 1) : r * (q + 1) + (xcd - r) * q) + off; }
        const int nig = WGM * nN, gid = wgid / nig, fm = gid * WGM, gsz = (nM - fm) < WGM ? (nM - fm) : WGM;
        u.pm = fm + ((wgid % nig) % gsz); u.pn = (wgid % nig) / gsz; return true;
    }
    __device__ __forceinline__ void a_ready(const Unit&) const {}
    __device__ __forceinline__ void done(const Unit&) const {}
};

typedef __bf16 bf16v2_t __attribute__((ext_vector_type(2)));
typedef float f32v2_t __attribute__((ext_vector_type(2)));
__device__ __forceinline__ unsigned cvt_pk_bf16(float lo, float hi) { const f32v2_t v = {lo, hi}; const bf16v2_t b = __builtin_convertvector(v, bf16v2_t); return __builtin_bit_cast(unsigned, b); }
__device__ __forceinline__ unsigned short f2bf1(float f) { return (unsigned short)(cvt_pk_bf16(f, 0.f) & 0xffffu); }

struct EpiProj {
    static constexpr bool PERM = true, AFTER_DRAIN = false;
    bf16_t* O; int ldc; int ncols; bf16_t* VT; const float* rowss; const float* shw;
    __device__ __forceinline__ void operator()(const f32x4 (&acc)[2][2][4][2], const Unit& u, int wr, int wc, int fr, int fq) const {
        const int row0 = u.pm * BM + wr * 64 + fr, col0 = u.pn * BM + wc * 32 + 8 * fq;
        const bool dov = (VT != nullptr) && (u.pn == 6);
        const int vc = wc * 32 + 8 * fq, b = (u.pm * BM) >> 11;
        bf16_t* vbase = VT + ((size_t)((b * 2 + (vc >> 6)) * 64 + (vc & 63))) * 2048 + (row0 & 2047);
        f32x4 sh[2][2];
#pragma unroll
        for (int bj = 0; bj < 2; ++bj) { sh[bj][0] = *(const f32x4*)(shw + b * 3328 + col0 + bj * HALF); sh[bj][1] = *(const f32x4*)(shw + b * 3328 + col0 + bj * HALF + 4); }
        float rs[2][4];
#pragma unroll
        for (int ai = 0; ai < 2; ++ai)
#pragma unroll
            for (int m = 0; m < 4; ++m) rs[ai][m] = rowss[row0 + ai * HALF + m * 16];
#pragma unroll
        for (int ai = 0; ai < 2; ++ai)
#pragma unroll
            for (int m = 0; m < 4; ++m) { const int row = row0 + ai * HALF + m * 16; bf16_t* rowp = O + (size_t)row * ldc + col0;
                const float r = __builtin_amdgcn_rsqf(rs[ai][m] * (1.0f / 1024.0f) + 1e-6f);
#pragma unroll
                for (int bj = 0; bj < 2; ++bj) { const f32x4 v0 = acc[ai][bj][m][0] * r + sh[bj][0], v1 = acc[ai][bj][m][1] * r + sh[bj][1];
                    u32x4 w; w.x = cvt_pk_bf16(v0[0], v0[1]); w.y = cvt_pk_bf16(v0[2], v0[3]); w.z = cvt_pk_bf16(v1[0], v1[1]); w.w = cvt_pk_bf16(v1[2], v1[3]);
                    if (col0 + bj * HALF < ncols) *(u32x4*)(rowp + bj * HALF) = w;
                    if (bj == 1 && dov) { bf16_t* vp = vbase + ai * HALF + m * 16;
                        vp[0 * 2048] = (bf16_t)(w.x & 0xffffu); vp[1 * 2048] = (bf16_t)(w.x >> 16); vp[2 * 2048] = (bf16_t)(w.y & 0xffffu); vp[3 * 2048] = (bf16_t)(w.y >> 16);
                        vp[4 * 2048] = (bf16_t)(w.z & 0xffffu); vp[5 * 2048] = (bf16_t)(w.z >> 16); vp[6 * 2048] = (bf16_t)(w.w & 0xffffu); vp[7 * 2048] = (bf16_t)(w.w >> 16); } }
                asm volatile("" ::: "memory"); }
    }
};
struct EpiOut {
    static constexpr bool PERM = false, AFTER_DRAIN = false;
    const float* xin; float* xout; const float* gate;
    bf16_t* hp; const float* nwn; const float* scn; float* rssn;
    __device__ __forceinline__ void operator()(const f32x4 (&acc)[2][2][4][2], const Unit& u, int wr, int wc, int fr, int fq) const {
        const int row0 = u.pm * BM + wr * 64 + fr, col0 = u.pn * BM + wc * 32 + 4 * fq, b = (u.pm * BM) >> 11;
        const bool nx = hp != nullptr;
        f32x4 g[2][2], ws[2][2];
#pragma unroll
        for (int bj = 0; bj < 2; ++bj)
#pragma unroll
            for (int n = 0; n < 2; ++n) { const int c = col0 + bj * HALF + n * 16; g[bj][n] = *(const f32x4*)(gate + b * 3072 + c);
                ws[bj][n] = *(const f32x4*)(nwn + c) * (*(const f32x4*)(scn + b * 3072 + c) + 1.0f); }
#pragma unroll
        for (int ai = 0; ai < 2; ++ai)
#pragma unroll
            for (int m = 0; m < 4; ++m) { const int row = row0 + ai * HALF + m * 16; const size_t off = (size_t)row * 1024 + col0; float ss = 0.f;
#pragma unroll
                for (int bj = 0; bj < 2; ++bj)
#pragma unroll
                    for (int n = 0; n < 2; ++n) { const f32x4 xo = *(const f32x4*)(xin + off + bj * HALF + n * 16); const f32x4 xn = xo + g[bj][n] * acc[ai][bj][m][n];
                        *(f32x4*)(xout + off + bj * HALF + n * 16) = xn;
                        if (nx) { ss += (xn[0] * xn[0] + xn[1] * xn[1]) + (xn[2] * xn[2] + xn[3] * xn[3]); const f32x4 h = xn * ws[bj][n];
                            u32x2 w; w.x = cvt_pk_bf16(h[0], h[1]); w.y = cvt_pk_bf16(h[2], h[3]); *(u32x2*)(hp + off + bj * HALF + n * 16) = w; } }
                if (nx) { ss += __shfl_xor(ss, 16); ss += __shfl_xor(ss, 32); if (fq == 0) atomicAdd(rssn + row, ss); }
                asm volatile("" ::: "memory"); }
    }
};

template <class Epi, class Sched, bool ALIGN_EPI = false, bool SP2 = false>
__device__ __forceinline__ void gemm_phase(PG8_LAS unsigned char* lds, const Gemm g, const Sched& S, const Epi& E) {
    int tid_ = threadIdx.x; asm volatile("" : "+v"(tid_));
    const int tid = tid_, wid = __builtin_amdgcn_readfirstlane(tid >> 6), lane = tid & 63, wr = wid >> 2, wc = wid & 3, fr = lane & 15, fq = lane >> 4;
    const int K = g.K, nt = K / BK;
    unsigned voffA[2], voffB[2];
#pragma unroll
    for (int i = 0; i < 2; ++i) { int R, C; stage_rc(tid * 16 + i * 8192, R, C); const int Rb = Epi::PERM ? ((R & ~31) + perm32(R & 31)) : R;
        voffA[i] = (unsigned)(R * K + C) * 2u; voffB[i] = (unsigned)(Rb * K + C) * 2u; }
    const size_t kstep = (size_t)(BK * 2);
    const size_t hstep = (size_t)HALF * K * 2;
    const size_t tstep = 2 * hstep;
    const unsigned ldsw = (unsigned)wid * 1024u;
    const int aoff = lds_byte(wr * 64 + fr, fq * 8), boff = lds_byte(wc * 32 + fr, fq * 8);
#define PG8_SA(b, h) (((b) * 2 + (h)) * HTB)
#define PG8_SB(b, h) ((4 + (b) * 2 + (h)) * HTB)
#define PG8_STAGE(bufoff, gbase, voff) do { _Pragma("unroll") for (int _i = 0; _i < 2; ++_i) \
        __builtin_amdgcn_global_load_lds((const unsigned*)((const char*)(gbase) + (voff)[_i]), (PG8_LAS unsigned*)(lds + (bufoff) + ldsw + _i * 8192), 16, 0, 0); } while (0)
#define PG8_LDA(dst, b, h) do { _Pragma("unroll") for (int m = 0; m < 4; ++m) _Pragma("unroll") for (int k = 0; k < 2; ++k) dst[m][k] = *(const PG8_LAS bf16x8*)(lds + PG8_SA(b, h) + aoff + m * 2048 + k * 1024); } while (0)
#define PG8_LDB(dst, b, h) do { _Pragma("unroll") for (int n = 0; n < 2; ++n) _Pragma("unroll") for (int k = 0; k < 2; ++k) dst[n][k] = *(const PG8_LAS bf16x8*)(lds + PG8_SB(b, h) + boff + n * 2048 + k * 1024); } while (0)
#define PG8_MMA(ai, bj, At, Bt) do { __builtin_amdgcn_s_setprio(1); _Pragma("unroll") for (int m = 0; m < 4; ++m) _Pragma("unroll") for (int n = 0; n < 2; ++n) _Pragma("unroll") for (int k = 0; k < 2; ++k) \
        acc[ai][bj][m][n] = __builtin_amdgcn_mfma_f32_16x16x32_bf16(Bt[n][k], At[m][k], acc[ai][bj][m][n], 0, 0, 0); __builtin_amdgcn_s_setprio(0); } while (0)
#define PG8_WAIT_V(n) asm volatile("s_waitcnt vmcnt(" #n ")" ::: "memory")
#define PG8_WAIT_L(n) asm volatile("s_waitcnt lgkmcnt(" #n ")" ::: "memory")
#define PG8_BAR __builtin_amdgcn_s_barrier()
#define PG8_SCHED __builtin_amdgcn_sched_barrier(0)
    Unit cur, nxt; int ui = 0;
    if (!S.next(0, cur)) return;
    f32x4 acc[2][2][4][2];
#pragma unroll
    for (int a = 0; a < 2; ++a)
#pragma unroll
        for (int b = 0; b < 2; ++b)
#pragma unroll
            for (int m = 0; m < 4; ++m)
#pragma unroll
                for (int n = 0; n < 2; ++n) acc[a][b][m][n] = (f32x4){0.f, 0.f, 0.f, 0.f};
    bf16x8 At[4][2], B0[2][2], B1[2][2];
    const char* cA = (const char*)g.A + (size_t)cur.pm * tstep; const char* cB = (const char*)g.Bt + (size_t)cur.pn * tstep;
    S.a_ready(cur);
    if constexpr (SP2) {
        PG8_STAGE(PG8_SB(0, 0), cB, voffB); PG8_STAGE(PG8_SB(0, 1), cB + hstep, voffB); PG8_STAGE(PG8_SA(0, 0), cA, voffA); PG8_STAGE(PG8_SA(0, 1), cA + hstep, voffA);
        if (wr == 1) PG8_BAR;
        PG8_WAIT_V(2); PG8_BAR;
        PG8_STAGE(PG8_SB(1, 0), cB + kstep, voffB); PG8_STAGE(PG8_SA(1, 0), cA + kstep, voffA); PG8_STAGE(PG8_SB(1, 1), cB + hstep + kstep, voffB);
        PG8_WAIT_V(6); PG8_BAR;
    } else {
        PG8_STAGE(PG8_SB(0, 0), cB, voffB); PG8_STAGE(PG8_SA(0, 0), cA, voffA); PG8_STAGE(PG8_SB(0, 1), cB + hstep, voffB); PG8_STAGE(PG8_SA(0, 1), cA + hstep, voffA);
        if (wr == 1) PG8_BAR;
        PG8_WAIT_V(4); PG8_BAR;
        PG8_STAGE(PG8_SB(1, 0), cB + kstep, voffB); PG8_STAGE(PG8_SA(1, 0), cA + kstep, voffA); PG8_STAGE(PG8_SB(1, 1), cB + hstep + kstep, voffB);
        PG8_WAIT_V(6); PG8_BAR;
    }
    for (;;) {
        const bool has_next = S.next(ui + 1, nxt);
        const char* nA = has_next ? (const char*)g.A + (size_t)nxt.pm * tstep : cA; const char* nB = has_next ? (const char*)g.Bt + (size_t)nxt.pn * tstep : cB;
        for (int t = 0; t < nt; t += 2) {
            const bool last = (t == nt - 2);
            const char* a1 = cA + (size_t)(t + 1) * kstep;
            const char* a2 = last ? nA : cA + (size_t)(t + 2) * kstep; const char* b2 = last ? nB : cB + (size_t)(t + 2) * kstep;
            const char* a3 = a2 + kstep; const char* b3 = b2 + kstep;
            if (last && has_next) S.a_ready(nxt);
            if constexpr (SP2) {
            PG8_LDB(B0, 0, 0); PG8_LDB(B1, 0, 1); PG8_SCHED; PG8_LDA(At, 0, 0); PG8_STAGE(PG8_SA(1, 1), a1 + hstep, voffA);
            PG8_WAIT_V(8); PG8_WAIT_L(0); PG8_BAR; PG8_MMA(0, 0, At, B0); PG8_MMA(0, 1, At, B1); PG8_BAR; PG8_SCHED;
            PG8_LDA(At, 0, 1); PG8_STAGE(PG8_SB(0, 0), b2, voffB); PG8_STAGE(PG8_SB(0, 1), b2 + hstep, voffB); PG8_STAGE(PG8_SA(0, 0), a2, voffA);
            PG8_WAIT_V(8); PG8_WAIT_L(0); PG8_BAR; PG8_MMA(1, 0, At, B0); PG8_MMA(1, 1, At, B1); PG8_BAR; PG8_SCHED;
            PG8_LDB(B0, 1, 0); PG8_LDB(B1, 1, 1); PG8_SCHED; PG8_LDA(At, 1, 0); PG8_STAGE(PG8_SA(0, 1), a2 + hstep, voffA);
            PG8_WAIT_V(8); PG8_WAIT_L(0); PG8_BAR; PG8_MMA(0, 0, At, B0); PG8_MMA(0, 1, At, B1); PG8_BAR; PG8_SCHED;
            PG8_LDA(At, 1, 1); PG8_STAGE(PG8_SB(1, 0), b3, voffB); PG8_STAGE(PG8_SB(1, 1), b3 + hstep, voffB); PG8_STAGE(PG8_SA(1, 0), a3, voffA);
            PG8_WAIT_V(8); PG8_WAIT_L(0); PG8_BAR; PG8_MMA(1, 0, At, B0); PG8_MMA(1, 1, At, B1); PG8_BAR; PG8_SCHED;
            } else {
            PG8_LDB(B0, 0, 0); PG8_SCHED; PG8_LDA(At, 0, 0); PG8_STAGE(PG8_SA(1, 1), a1 + hstep, voffA);
            PG8_WAIT_L(8); PG8_BAR; PG8_WAIT_L(0); PG8_MMA(0, 0, At, B0); PG8_BAR; PG8_SCHED;
            PG8_LDB(B1, 0, 1); PG8_STAGE(PG8_SB(0, 0), b2, voffB);
            PG8_BAR; PG8_WAIT_L(0); PG8_MMA(0, 1, At, B1); PG8_BAR;
            PG8_LDA(At, 0, 1); PG8_STAGE(PG8_SA(0, 0), a2, voffA);
            PG8_BAR; PG8_WAIT_L(0); PG8_MMA(1, 0, At, B0); PG8_BAR; PG8_SCHED;
            PG8_STAGE(PG8_SB(0, 1), b2 + hstep, voffB);
            PG8_WAIT_V(6); PG8_BAR; PG8_MMA(1, 1, At, B1); PG8_BAR;
            PG8_LDB(B0, 1, 0); PG8_SCHED; PG8_LDA(At, 1, 0); PG8_STAGE(PG8_SA(0, 1), a2 + hstep, voffA);
            PG8_WAIT_L(8); PG8_BAR; PG8_WAIT_L(0); PG8_MMA(0, 0, At, B0); PG8_BAR; PG8_SCHED;
            PG8_LDB(B1, 1, 1); PG8_STAGE(PG8_SB(1, 0), b3, voffB);
            PG8_BAR; PG8_WAIT_L(0); PG8_MMA(0, 1, At, B1); PG8_BAR;
            PG8_LDA(At, 1, 1); PG8_STAGE(PG8_SA(1, 0), a3, voffA);
            PG8_BAR; PG8_WAIT_L(0); PG8_MMA(1, 0, At, B0); PG8_BAR; PG8_SCHED;
            PG8_STAGE(PG8_SB(1, 1), b3 + hstep, voffB);
            PG8_WAIT_V(6); PG8_BAR; PG8_MMA(1, 1, At, B1); PG8_BAR;
            }
        }
        if constexpr (ALIGN_EPI) { if (wr == 0) PG8_BAR; }
        if constexpr (!Epi::AFTER_DRAIN) { E(acc, cur, wr, wc, fr, fq); S.done(cur); }
        if (!has_next) break;
#pragma unroll
        for (int a = 0; a < 2; ++a)
#pragma unroll
            for (int b = 0; b < 2; ++b)
#pragma unroll
                for (int m = 0; m < 4; ++m)
#pragma unroll
                    for (int n = 0; n < 2; ++n) acc[a][b][m][n] = (f32x4){0.f, 0.f, 0.f, 0.f};
        cur = nxt; cA = nA; cB = nB; ++ui;
        if constexpr (ALIGN_EPI) { if (wr == 1) PG8_BAR; }
    }
    PG8_WAIT_V(0);
    if constexpr (!ALIGN_EPI) { if (wr == 0) PG8_BAR; }
    PG8_BAR;
    if constexpr (Epi::AFTER_DRAIN) { E.fused(acc, cur, wr, wc, fr, fq, lds, wid, lane); S.done(cur); }
#undef PG8_SA
#undef PG8_SB
#undef PG8_STAGE
#undef PG8_LDA
#undef PG8_LDB
#undef PG8_MMA
#undef PG8_WAIT_V
#undef PG8_WAIT_L
#undef PG8_BAR
#undef PG8_SCHED
}
}

using pg8::bf16_t; using pg8::bf16x8; using pg8::f32x4; using pg8::u32x4; using pg8::cvt_pk_bf16; using pg8::f2bf1;
#define LAS __attribute__((address_space(3)))
using pg8::u32x2;
constexpr int D = 1024, NB = 32, SEQ = 2048, MTOK = NB * SEQ, DEPTH = 4;
constexpr int EVEN_IN = 2304, ODD_IN = 3104, ODD_INP = 3328;
constexpr int LDS_BYTES = 147456;
constexpr size_t MiB = 1u << 20;
constexpr size_t WS_MOD = 0;
constexpr size_t WS_WINA = 2 * MiB;
constexpr size_t WS_WOUTA = 12 * MiB;
constexpr size_t WS_WINC = 16 * MiB;
constexpr size_t WS_WOUTC = 30 * MiB;
constexpr size_t WS_WPT = 34 * MiB;
constexpr size_t WS_VT = 36 * MiB;
constexpr size_t WS_H = 64 * MiB;
constexpr size_t WS_OF = 192 * MiB;
constexpr size_t WS_OB = 320 * MiB;
constexpr size_t WS_PROJ = 448 * MiB;
constexpr size_t WS_HP = 840 * MiB;
constexpr size_t WS_ROWSS = 968 * MiB;
constexpr size_t WS_SHW = 970 * MiB;
constexpr size_t WS_SST = 972 * MiB;
constexpr size_t WS_END = 1004 * MiB;

__device__ __forceinline__ float bf2f(unsigned short b) { return __uint_as_float(((unsigned)b) << 16); }
__device__ __forceinline__ float bflo(unsigned w) { return __uint_as_float(w << 16); }
__device__ __forceinline__ float bfhi(unsigned w) { return __uint_as_float(w & 0xffff0000u); }
__device__ __forceinline__ float siluf(float z) { return z * __builtin_amdgcn_rcpf(1.0f + __builtin_amdgcn_exp2f(-1.4426950408889634f * z)); }
__device__ __forceinline__ f32x4 mfma16(bf16x8 a, bf16x8 b, f32x4 c) { return __builtin_amdgcn_mfma_f32_16x16x32_bf16(a, b, c, 0, 0, 0); }
__device__ __forceinline__ bf16x8 as_bf16x8(u32x4 v) { return __builtin_bit_cast(bf16x8, v); }

#define RLX_AGENT __ATOMIC_RELAXED, __HIP_MEMORY_SCOPE_AGENT
constexpr size_t WS_BAR = 1792 * 1024;
constexpr int LDS_MISC = 147456 - 64;
#define XB_TMO      128
#define XB_XCNT(j)  (256  + 64 * (j))
#define XB_XSUB(j)  (1280 + 64 * (j))
#define XB_XGEN(j)  (2304 + 64 * (j))
#define XB_TOP      3328
#define XB_TOPGEN   3392
#define XCD_BAR_WORDS 3456
#define XB_SPIN_CAP (1u << 18)

__device__ __forceinline__ unsigned xb_ld(unsigned* p)              { return __hip_atomic_load(p, __ATOMIC_RELAXED, __HIP_MEMORY_SCOPE_AGENT); }
__device__ __forceinline__ unsigned xb_add(unsigned* p, unsigned v) { return __hip_atomic_fetch_add(p, v, __ATOMIC_RELAXED, __HIP_MEMORY_SCOPE_AGENT); }
__device__ __forceinline__ unsigned xb_xcc_id() { return (unsigned)__builtin_amdgcn_s_getreg((3 << 11) | 20) & 0xFu; }
#define XB_SPIN(cond, bar) do { unsigned _sp = 0; while (cond) { __builtin_amdgcn_s_sleep(1); \
    if ((++_sp & 255u) == 0u) { if (xb_ld(&(bar)[XB_TMO])) break; if (_sp > XB_SPIN_CAP) { atomicAdd(&(bar)[XB_TMO], 1u); break; } } } } while (0)

struct XcdBarrier {
    unsigned* bar; unsigned x;
    volatile LAS unsigned* st;
};

__device__ __forceinline__ XcdBarrier xcd_barrier_post(unsigned* bar, volatile LAS unsigned* st) {
    XcdBarrier b; b.bar = bar; b.x = xb_xcc_id(); b.st = st;
    if (threadIdx.x == 0) (void)xb_add(&bar[XB_XCNT(b.x)], 1u);
    return b;
}
__device__ __forceinline__ void xcd_barrier_complete(unsigned* bar, unsigned x, unsigned& nloc, unsigned& nx) {
    const unsigned G = gridDim.x * gridDim.y * gridDim.z;
    unsigned sum, cnt, mine, sp = 0u;
    for (;;) {
        sum = 0u; cnt = 0u; mine = 0u;
#pragma unroll
        for (unsigned j = 0; j < 16; ++j) { const unsigned c = xb_ld(&bar[XB_XCNT(j)]); sum += c; cnt += (c > 0u) ? 1u : 0u; mine = (j == x) ? c : mine; }
        if (sum == G) break;
        __builtin_amdgcn_s_sleep(1);
        if ((++sp & 255u) == 0u) { if (xb_ld(&bar[XB_TMO])) break; if (sp > XB_SPIN_CAP) { atomicAdd(&bar[XB_TMO], 1u); break; } }
    }
    nloc = mine > 0u ? mine : 1u; nx = cnt > 0u ? cnt : 1u;
}

__device__ __forceinline__ void xcd_barrier(const XcdBarrier& b) {
    asm volatile("s_waitcnt vmcnt(0)" ::: "memory");
    __syncthreads();
    if (threadIdx.x == 0) {
        unsigned* bar = b.bar;
        __builtin_amdgcn_s_waitcnt(0);
        unsigned nloc = b.st[0], nx = b.st[1];
        if (nloc == 0u) { xcd_barrier_complete(bar, b.x, nloc, nx); b.st[0] = nloc; b.st[1] = nx; }
        const unsigned old = xb_add(&bar[XB_XSUB(b.x)], 1u);
        const unsigned gen = old / nloc;
        if (old + 1u == (gen + 1u) * nloc) {
            __builtin_amdgcn_fence(__ATOMIC_RELEASE, "agent");
            asm volatile("s_waitcnt vmcnt(0)" ::: "memory");
            const unsigned og = xb_add(&bar[XB_TOP], 1u);
            const unsigned tg = og / nx;
            if (og + 1u == (tg + 1u) * nx) xb_add(&bar[XB_TOPGEN], 1u);
            else XB_SPIN(xb_ld(&bar[XB_TOPGEN]) == tg, bar);
            __builtin_amdgcn_fence(__ATOMIC_ACQUIRE, "agent");
            xb_add(&bar[XB_XGEN(b.x)], 1u);
            asm volatile("s_waitcnt vmcnt(0)" ::: "memory");
        } else {
            XB_SPIN(xb_ld(&bar[XB_XGEN(b.x)]) == gen, bar);
            __builtin_amdgcn_fence(__ATOMIC_ACQUIRE, "agent");
            asm volatile("s_waitcnt vmcnt(0)" ::: "memory");
        }
    }
    __syncthreads();
}

#ifndef GEMM_SP2
#define GEMM_SP2 true
#endif
#ifndef GEMM_ALIGN
#define GEMM_ALIGN true
#endif
struct Ctx { int tid, lane, wid, vcu, G; };

__device__ __forceinline__ void small_gemm_item(LAS unsigned char* lds, const Ctx& X, const float* src, int srcS, bool use_silu, const float* W, int ldw, int ncols, int n0, const float* bias, float* out, int outS) {
    LAS float* SC = (LAS float*)lds;
    __syncthreads();
#pragma unroll
    for (int it = 0; it < 16; ++it) { const int t = X.tid + 512 * it, b = t >> 8, k4 = t & 255; f32x4 v = *(const f32x4*)(src + (size_t)b * srcS + 4 * k4);
        if (use_silu) { v[0] = siluf(v[0]); v[1] = siluf(v[1]); v[2] = siluf(v[2]); v[3] = siluf(v[3]); }
        *(LAS f32x4*)(SC + b * 1024 + 4 * k4) = v; }
    __syncthreads();
    float acc[32];
#pragma unroll
    for (int b = 0; b < 32; ++b) acc[b] = 0.f;
    const int nc = (n0 + X.lane < ncols) ? n0 + X.lane : ncols - 1;
    const float* wp = W + (size_t)(X.wid * 128) * ldw + nc;
#pragma unroll 4
    for (int k = 0; k < 128; k += 4) { const float w0 = wp[(size_t)k * ldw], w1 = wp[(size_t)(k + 1) * ldw], w2 = wp[(size_t)(k + 2) * ldw], w3 = wp[(size_t)(k + 3) * ldw];
#pragma unroll
        for (int b = 0; b < 32; ++b) { const f32x4 s4 = *(const LAS f32x4*)(SC + b * 1024 + X.wid * 128 + k); acc[b] += (s4[0] * w0 + s4[1] * w1) + (s4[2] * w2 + s4[3] * w3); } }
    __syncthreads();
    LAS float* RED = (LAS float*)lds;
#pragma unroll
    for (int b = 0; b < 32; ++b) RED[(X.wid * 32 + b) * 64 + X.lane] = acc[b];
    __syncthreads();
    for (int o = X.tid; o < 2048; o += 512) { const int b = o >> 6, nn = o & 63; float sv = bias ? bias[n0 + nn < ncols ? n0 + nn : ncols - 1] : 0.f;
#pragma unroll
        for (int w = 0; w < 8; ++w) sv += RED[(w * 32 + b) * 64 + nn];
        if (n0 + nn < ncols) out[(size_t)b * outS + n0 + nn] = sv; }
}
__device__ __forceinline__ void mod_phase(LAS unsigned char* lds, const Ctx& X, const float* c, const float* w_ada, const float* b_ada, float* mod) {
    for (int item = X.vcu; item < 192; item += X.G) { const int l = item / 48, n0 = (item % 48) * 64;
        small_gemm_item(lds, X, c, 1024, true, w_ada + (size_t)l * 1024 * 3072, 3072, 3072, n0, b_ada + l * 3072, mod + (size_t)l * 32 * 3072, 3072); }
    __syncthreads();
}
__device__ __forceinline__ void shiftw_phase(LAS unsigned char* lds, const Ctx& X, const float* mod, const float* w_in_a, const float* w_in_c, float* shw) {
    for (int item = X.vcu; item < 170; item += X.G) {
        int l, j; if (item < 36) { l = 0; j = item; } else if (item < 85) { l = 1; j = item - 36; } else if (item < 121) { l = 2; j = item - 85; } else { l = 3; j = item - 121; }
        const bool odd = (l & 1) != 0; const int N = odd ? ODD_IN : EVEN_IN;
        const float* W = odd ? w_in_c + (size_t)(l >> 1) * 1024 * ODD_IN : w_in_a + (size_t)(l >> 1) * 1024 * EVEN_IN;
        small_gemm_item(lds, X, mod + (size_t)l * 32 * 3072, 3072, false, W, N, N, j * 64, nullptr, shw + (size_t)l * 32 * 3328, 3328); }
    __syncthreads();
}

__device__ __forceinline__ void transpose_item(const float* W, int K, int N, bf16_t* WT, LAS float* scr, int item, int lane) {
    const int nblk = N / 32, kb = item / nblk, nb = item % nblk, k0 = 64 * kb, n0 = 32 * nb;
#pragma unroll 8
    for (int i = 0; i < 32; ++i) { const int kk = 2 * i + (lane >> 5); scr[kk * 33 + (lane & 31)] = W[(size_t)(k0 + kk) * N + n0 + (lane & 31)]; }
    asm volatile("s_waitcnt lgkmcnt(0)" ::: "memory");
    const int c = lane & 7;
#pragma unroll
    for (int j = 0; j < 4; ++j) { const int n = (lane >> 3) + 8 * j; const LAS float* s = scr + (8 * c) * 33 + n;
        u32x4 o; o.x = cvt_pk_bf16(s[0 * 33], s[1 * 33]); o.y = cvt_pk_bf16(s[2 * 33], s[3 * 33]); o.z = cvt_pk_bf16(s[4 * 33], s[5 * 33]); o.w = cvt_pk_bf16(s[6 * 33], s[7 * 33]);
        *(u32x4*)(WT + (size_t)(n0 + n) * K + k0 + 8 * c) = o; }
    asm volatile("s_waitcnt lgkmcnt(0)" ::: "memory");
}
struct WPtrs { const float *w_in_a, *w_out_a, *w_in_c, *w_out_c, *w_pool; };
__device__ __forceinline__ void transpose_phase(LAS unsigned char* lds, const Ctx& X, const WPtrs& P, unsigned char* ws) {
    LAS float* scr = (LAS float*)(lds + X.wid * 16384);
    const int gw = X.vcu * 8 + X.wid, NGW = X.G * 8;
    constexpr int I_INA = 16 * 72, I_OUT = 16 * 32, I_INC = 16 * 97, I_POOL = 2 * 4;
    constexpr int NITEMS = 2 * I_INA + 2 * I_OUT + 2 * I_INC + 2 * I_OUT + 8 * I_POOL;
    for (int it = gw; it < NITEMS; it += NGW) {
        int r = it;
        if (r < 2 * I_INA) { const int i = r / I_INA; transpose_item(P.w_in_a + (size_t)i * 1024 * EVEN_IN, 1024, EVEN_IN, (bf16_t*)(ws + WS_WINA) + (size_t)i * EVEN_IN * 1024, scr, r % I_INA, X.lane); continue; } r -= 2 * I_INA;
        if (r < 2 * I_OUT) { const int i = r / I_OUT; transpose_item(P.w_out_a + (size_t)i * 1024 * 1024, 1024, 1024, (bf16_t*)(ws + WS_WOUTA) + (size_t)i * 1024 * 1024, scr, r % I_OUT, X.lane); continue; } r -= 2 * I_OUT;
        if (r < 2 * I_INC) { const int i = r / I_INC; transpose_item(P.w_in_c + (size_t)i * 1024 * ODD_IN, 1024, ODD_IN, (bf16_t*)(ws + WS_WINC) + (size_t)i * ODD_INP * 1024, scr, r % I_INC, X.lane); continue; } r -= 2 * I_INC;
        if (r < 2 * I_OUT) { const int i = r / I_OUT; transpose_item(P.w_out_c + (size_t)i * 1024 * 1024, 1024, 1024, (bf16_t*)(ws + WS_WOUTC) + (size_t)i * 1024 * 1024, scr, r % I_OUT, X.lane); continue; } r -= 2 * I_OUT;
        { const int i = r / I_POOL; transpose_item(P.w_pool + (size_t)i * 16384, 128, 128, (bf16_t*)(ws + WS_WPT) + (size_t)i * 16384, scr, r % I_POOL, X.lane); }
    }
    for (int t = (X.vcu * 512 + X.tid); t < 2 * 224 * 128; t += X.G * 512) { const int i = t / (224 * 128), rr = t % (224 * 128);
        *(u32x4*)((bf16_t*)(ws + WS_WINC) + ((size_t)i * ODD_INP + ODD_IN) * 1024 + (size_t)rr * 8) = (u32x4){0u, 0u, 0u, 0u}; }
}

__device__ __forceinline__ float wave_sum(float v) {
#pragma unroll
    for (int o = 1; o < 64; o <<= 1) v += __shfl_xor(v, o);
    return v;
}
__device__ __forceinline__ void prenorm_phase(const Ctx& X, const float* x, const float* nw, const float* modl, bf16_t* hp, float* rowss) {
    const int gw = X.vcu * 8 + X.wid, NGW = X.G * 8;
#pragma unroll 2
    for (int m = gw; m < MTOK; m += NGW) {
        const int b = m >> 11;
        const f32x4* xr = (const f32x4*)(x + (size_t)m * D) + X.lane;
        f32x4 v[4]; float s = 0.f;
#pragma unroll
        for (int j = 0; j < 4; ++j) { v[j] = xr[64 * j]; s += (v[j][0] * v[j][0] + v[j][1] * v[j][1]) + (v[j][2] * v[j][2] + v[j][3] * v[j][3]); }
        s = wave_sum(s); if (X.lane == 0) rowss[m] = s;
        const f32x4* nwp = (const f32x4*)nw + X.lane; const f32x4* scp = (const f32x4*)(modl + b * 3072 + 1024) + X.lane;
        u32x2* o8 = (u32x2*)(hp + (size_t)m * D) + X.lane;
#pragma unroll
        for (int j = 0; j < 4; ++j) { const f32x4 y = v[j] * nwp[64 * j] * (scp[64 * j] + 1.0f);
            u32x2 o; o.x = cvt_pk_bf16(y[0], y[1]); o.y = cvt_pk_bf16(y[2], y[3]); o8[64 * j] = o; }
    }
}

template <int HW> __device__ __forceinline__ void pool_window(LAS unsigned char* lds, int U_OFF, int P_OFF, int US, int tid, int s0) {
    const int cp = tid & 63, t0 = 16 * (tid >> 6);
    constexpr int NR = 16 + 2 * HW - 1;
    unsigned rw[NR];
#pragma unroll
    for (int k = 0; k < NR; ++k) rw[k] = *(const LAS unsigned*)(lds + U_OFF + (t0 + 8 - HW + k) * US + cp * 4);
    float a0 = 0.f, a1 = 0.f;
#pragma unroll
    for (int k = 0; k < 2 * HW; ++k) { a0 += bflo(rw[k]); a1 += bfhi(rw[k]); }
#pragma unroll
    for (int it = 0; it < 16; ++it) { const int s = s0 + t0 + it;
        if (it > 0) { a0 += bflo(rw[2 * HW - 1 + it]) - bflo(rw[it - 1]); a1 += bfhi(rw[2 * HW - 1 + it]) - bfhi(rw[it - 1]); }
        int lo = s - HW, hi = s + HW - 1; lo = lo < 0 ? 0 : lo; hi = hi > SEQ - 1 ? SEQ - 1 : hi; const float inv = __builtin_amdgcn_rcpf((float)(hi - lo + 1));
        const unsigned uc = rw[HW + it];
        *(LAS unsigned*)(lds + P_OFF + (t0 + it) * US + cp * 4) = cvt_pk_bf16(a0 * inv - bflo(uc), a1 * inv - bfhi(uc)); }
}
__device__ __forceinline__ void pool_phase(LAS unsigned char* lds, const Ctx& X, const bf16_t* proj, const bf16_t* WpT, const float* pscale, bf16_t* mix) {
    constexpr int US = 272, U_OFF = 0, P_OFF = 144 * US, W_OFF = P_OFF + 128 * US;
    const int tid = X.tid, fr = X.lane & 15, fq = X.lane >> 4;
    u32x4 pu[5];
#define POOL_LOADU(item_) do { const int g_ = (item_) >> 9, tt_ = (item_) & 511, row0_ = tt_ * 128, b_ = row0_ >> 11, s0_ = row0_ & 2047; \
        _Pragma("unroll") for (int it = 0; it < 5; ++it) { const int t = tid + 512 * it, rr = t >> 4, pc = t & 15, s = s0_ - 8 + rr; pu[it] = (u32x4){0u, 0u, 0u, 0u}; \
            if (t < 144 * 16 && s >= 0 && s < SEQ) pu[it] = *(const u32x4*)(proj + ((size_t)b_ * SEQ + s) * EVEN_IN + g_ * 128 + pc * 8); } } while (0)
    if (X.vcu < 2048) POOL_LOADU(X.vcu);
    int gprev = -1;
    for (int item = X.vcu; item < 2048; item += X.G) {
        const int g = item >> 9, tt = item & 511, row0 = tt * 128, s0 = row0 & 2047; const bool neww = (g != gprev); gprev = g;
        const size_t tok = (size_t)row0 + 16 * X.wid + fr;
        u32x2 zr[8];
#pragma unroll
        for (int df = 0; df < 8; ++df) zr[df] = *(const u32x2*)(proj + tok * EVEN_IN + 512 + g * 128 + 16 * df + 4 * fq);
        u32x4 wv[4];
#pragma unroll
        for (int it = 0; it < 4; ++it) { const int t = tid + 512 * it, d = t >> 4, pc = t & 15; wv[it] = neww ? *(const u32x4*)(WpT + (size_t)g * 16384 + d * 128 + pc * 8) : (u32x4){0u, 0u, 0u, 0u}; }
        __syncthreads();
#pragma unroll
        for (int it = 0; it < 5; ++it) { const int t = tid + 512 * it, rr = t >> 4, pc = t & 15; if (t < 144 * 16) *(LAS u32x4*)(lds + U_OFF + rr * US + pc * 16) = pu[it]; }
        if (neww) {
#pragma unroll
        for (int it = 0; it < 4; ++it) { const int t = tid + 512 * it, d = t >> 4, pc = t & 15; *(LAS u32x4*)(lds + W_OFF + d * US + pc * 16) = wv[it]; } }
        { const int nxt = item + X.G < 2048 ? item + X.G : item; POOL_LOADU(nxt); }
        __syncthreads();
        if (g == 0) pool_window<1>(lds, U_OFF, P_OFF, US, tid, s0); else if (g == 1) pool_window<2>(lds, U_OFF, P_OFF, US, tid, s0);
        else if (g == 2) pool_window<4>(lds, U_OFF, P_OFF, US, tid, s0); else pool_window<8>(lds, U_OFF, P_OFF, US, tid, s0);
        __syncthreads();
        f32x4 acc[8];
#pragma unroll
        for (int df = 0; df < 8; ++df) acc[df] = (f32x4){0.f, 0.f, 0.f, 0.f};
#pragma unroll
        for (int ks = 0; ks < 4; ++ks) { const bf16x8 pb = *(const LAS bf16x8*)(lds + P_OFF + (16 * X.wid + fr) * US + ks * 64 + fq * 16);
#pragma unroll
            for (int df = 0; df < 8; ++df) { const bf16x8 wa = *(const LAS bf16x8*)(lds + W_OFF + (16 * df + fr) * US + ks * 64 + fq * 16); acc[df] = mfma16(wa, pb, acc[df]); } }
#pragma unroll
        for (int df = 0; df < 8; ++df) { const int c = g * 128 + 16 * df + 4 * fq; const f32x4 ps = *(const f32x4*)(pscale + c); const u32x2 z = zr[df];
            u32x2 o; o.x = cvt_pk_bf16(acc[df][0] * ps[0] * siluf(bflo(z.x)), acc[df][1] * ps[1] * siluf(bfhi(z.x))); o.y = cvt_pk_bf16(acc[df][2] * ps[2] * siluf(bflo(z.y)), acc[df][3] * ps[3] * siluf(bfhi(z.y)));
            *(u32x2*)(mix + tok * 1024 + c) = o; }
    }
#undef POOL_LOADU
    __syncthreads();
}

__device__ __forceinline__ void attn_phase(LAS unsigned char* lds, const Ctx& X, const bf16_t* proj, const bf16_t* VTg, const float* qw, const float* kw, const float* sink, bf16_t* mix) {
    constexpr int KS = 144, VS = 816, V_OFF = 384 * KS;
    const int tid = X.tid, wid = X.wid;
    for (int item = X.vcu; item < 1024; item += X.G) {
        const int kvh = item & 1, qb = (item >> 1) & 15, b = item >> 5, q0 = qb * 128; const size_t rowbase = (size_t)b * SEQ;
        __syncthreads();
        u32x4 kr[6];
#pragma unroll
        for (int it = 0; it < 6; ++it) { const int t = tid + 512 * it, jj = t >> 3, pc = t & 7, kpos = q0 - 128 + jj, kc = kpos < 0 ? 0 : (kpos > SEQ - 1 ? SEQ - 1 : kpos);
            kr[it] = *(const u32x4*)(proj + (rowbase + kc) * EVEN_IN + 1536 + kvh * 64 + pc * 8); }
#pragma unroll
        for (int it = 0; it < 6; ++it) { const int t = tid + 512 * it, jj = t >> 3, pc = t & 7, kpos = q0 - 128 + jj; const bool ok = (kpos >= 0) && (kpos < SEQ);
            u32x4 raw; raw.x = ok ? kr[it].x : 0u; raw.y = ok ? kr[it].y : 0u; raw.z = ok ? kr[it].z : 0u; raw.w = ok ? kr[it].w : 0u;
            float f[8]; f[0] = bflo(raw.x); f[1] = bfhi(raw.x); f[2] = bflo(raw.y); f[3] = bfhi(raw.y); f[4] = bflo(raw.z); f[5] = bfhi(raw.z); f[6] = bflo(raw.w); f[7] = bfhi(raw.w);
            float ss = 0.f;
#pragma unroll
            for (int e = 0; e < 8; ++e) ss += f[e] * f[e];
            ss += __shfl_xor(ss, 1); ss += __shfl_xor(ss, 2); ss += __shfl_xor(ss, 4);
            const float r = __builtin_amdgcn_rsqf(ss * (1.f / 64.f) + 1e-6f);
            const f32x4 w0 = *(const f32x4*)(kw + pc * 8), w1 = *(const f32x4*)(kw + pc * 8 + 4);
            u32x4 o; o.x = cvt_pk_bf16(f[0] * r * w0[0], f[1] * r * w0[1]); o.y = cvt_pk_bf16(f[2] * r * w0[2], f[3] * r * w0[3]); o.z = cvt_pk_bf16(f[4] * r * w1[0], f[5] * r * w1[1]); o.w = cvt_pk_bf16(f[6] * r * w1[2], f[7] * r * w1[3]);
            *(LAS u32x4*)(lds + jj * KS + pc * 16) = o; }
        u32x4 vr[7];
#pragma unroll
        for (int it = 0; it < 7; ++it) { const int t0 = tid + 512 * it, t = t0 < 64 * 50 ? t0 : 64 * 50 - 1, d = t / 50, pc = t % 50, kpos0 = q0 - 128 + pc * 8, kc = kpos0 < 0 ? 0 : (kpos0 > SEQ - 8 ? SEQ - 8 : kpos0);
            vr[it] = *(const u32x4*)(VTg + ((size_t)((b * 2 + kvh) * 64 + d)) * 2048 + kc); }
#pragma unroll
        for (int it = 0; it < 7; ++it) { const int t = tid + 512 * it, d = t / 50, pc = t % 50, jj0 = pc * 8, kpos0 = q0 - 128 + jj0; const bool ok = (jj0 < 384) && (kpos0 >= 0) && (kpos0 < SEQ);
            u32x4 v; v.x = ok ? vr[it].x : 0u; v.y = ok ? vr[it].y : 0u; v.z = ok ? vr[it].z : 0u; v.w = ok ? vr[it].w : 0u;
            if (t < 64 * 50) *(LAS u32x4*)(lds + V_OFF + d * VS + pc * 16) = v; }
        __syncthreads();
        const int hq = kvh * 4 + (wid >> 1), qh = wid & 1;
        const float L2E = 1.4426950408889634f;
        const float slope2 = exp2f(-(float)(hq + 1)) * L2E, sink2 = sink[hq] * L2E;
        u32x4 qr0, qr1; u32x2 zr[4];
#define ATT_LOADQ(qf_) do { int l_ = X.lane; asm volatile("" : "+v"(l_)); const size_t tq_ = rowbase + q0 + (qh * 4 + (qf_)) * 16 + (l_ & 15); \
            const bf16_t* qp_ = proj + tq_ * EVEN_IN + 1024 + hq * 64 + (l_ >> 4) * 8; qr0 = *(const u32x4*)qp_; qr1 = *(const u32x4*)(qp_ + 32); \
            _Pragma("unroll") for (int df = 0; df < 4; ++df) zr[df] = *(const u32x2*)(proj + tq_ * EVEN_IN + 1792 + hq * 64 + 16 * df + 4 * (l_ >> 4)); } while (0)
        ATT_LOADQ(0);
#pragma unroll 1
        for (int qf = 0; qf < 4; ++qf) {
            int ln = X.lane; asm volatile("" : "+v"(ln)); const int fr = ln & 15, fq = ln >> 4;
            const int qfi = qh * 4 + qf, qo = qfi * 16; const size_t tq = rowbase + q0 + qo + fr;
            bf16x8 Q0, Q1; u32x2 zc[4];
            { const u32x4 r0 = qr0, r1 = qr1;
#pragma unroll
              for (int df = 0; df < 4; ++df) zc[df] = zr[df];
              float f[16]; f[0] = bflo(r0.x); f[1] = bfhi(r0.x); f[2] = bflo(r0.y); f[3] = bfhi(r0.y); f[4] = bflo(r0.z); f[5] = bfhi(r0.z); f[6] = bflo(r0.w); f[7] = bfhi(r0.w);
              f[8] = bflo(r1.x); f[9] = bfhi(r1.x); f[10] = bflo(r1.y); f[11] = bfhi(r1.y); f[12] = bflo(r1.z); f[13] = bfhi(r1.z); f[14] = bflo(r1.w); f[15] = bfhi(r1.w);
              float ss = 0.f;
#pragma unroll
              for (int e = 0; e < 16; ++e) ss += f[e] * f[e];
              ss += __shfl_xor(ss, 16); ss += __shfl_xor(ss, 32);
              const float r = (0.125f * L2E) * __builtin_amdgcn_rsqf(ss * (1.f / 64.f) + 1e-6f);
              const f32x4 wa = *(const f32x4*)(qw + fq * 8), wb = *(const f32x4*)(qw + fq * 8 + 4), wc_ = *(const f32x4*)(qw + 32 + fq * 8), wd = *(const f32x4*)(qw + 32 + fq * 8 + 4);
              u32x4 a, c2;
              a.x = cvt_pk_bf16(f[0] * r * wa[0], f[1] * r * wa[1]); a.y = cvt_pk_bf16(f[2] * r * wa[2], f[3] * r * wa[3]); a.z = cvt_pk_bf16(f[4] * r * wb[0], f[5] * r * wb[1]); a.w = cvt_pk_bf16(f[6] * r * wb[2], f[7] * r * wb[3]);
              c2.x = cvt_pk_bf16(f[8] * r * wc_[0], f[9] * r * wc_[1]); c2.y = cvt_pk_bf16(f[10] * r * wc_[2], f[11] * r * wc_[3]); c2.z = cvt_pk_bf16(f[12] * r * wd[0], f[13] * r * wd[1]); c2.w = cvt_pk_bf16(f[14] * r * wd[2], f[15] * r * wd[3]);
              Q0 = as_bf16x8(a); Q1 = as_bf16x8(c2); }
            ATT_LOADQ(qf < 3 ? qf + 1 : 3);
            f32x4 s[17];
#pragma unroll
            for (int kf = 0; kf < 17; ++kf) { const LAS unsigned char* kp = lds + ((qfi + kf) * 16 + fr) * KS + fq * 16;
                f32x4 a = (f32x4){0.f, 0.f, 0.f, 0.f}; a = mfma16(*(const LAS bf16x8*)kp, Q0, a); a = mfma16(*(const LAS bf16x8*)(kp + 64), Q1, a); s[kf] = a; }
            const int posq = q0 + qo + fr; const float tf = (float)(4 * fq - fr);
            const float lo = fmaxf(-128.f, -(float)posq), hi = fminf(128.f, (float)(SEQ - 1 - posq));
            float mx = sink2;
            if (qb == 0 || qb == 15) {
#pragma unroll
                for (int kf = 0; kf < 17; ++kf)
#pragma unroll
                    for (int e = 0; e < 4; ++e) { const float d = tf + (float)(16 * kf + e - 128); const bool valid = (d >= lo) && (d <= hi);
                        const float v = valid ? s[kf][e] - slope2 * fabsf(d) : -1e30f; s[kf][e] = v; mx = fmaxf(mx, v); }
            } else {
#pragma unroll
                for (int kf = 0; kf < 17; ++kf)
#pragma unroll
                    for (int e = 0; e < 4; ++e) { const float d = tf + (float)(16 * kf + e - 128); float v = s[kf][e] - slope2 * fabsf(d);
                        if (kf == 0) v = (d >= -128.f) ? v : -1e30f;
                        if (kf == 16) v = (d <= 128.f) ? v : -1e30f;
                        s[kf][e] = v; mx = fmaxf(mx, v); }
            }
            mx = fmaxf(mx, __shfl_xor(mx, 16)); mx = fmaxf(mx, __shfl_xor(mx, 32));
            float sum = 0.f;
#pragma unroll
            for (int kf = 0; kf < 17; ++kf)
#pragma unroll
                for (int e = 0; e < 4; ++e) { const float p = __builtin_amdgcn_exp2f(s[kf][e] - mx); s[kf][e] = p; sum += p; }
            sum += __shfl_xor(sum, 16); sum += __shfl_xor(sum, 32);
            const float inv = __builtin_amdgcn_rcpf(sum + __builtin_amdgcn_exp2f(sink2 - mx));
            f32x4 o[4];
#pragma unroll
            for (int df = 0; df < 4; ++df) o[df] = (f32x4){0.f, 0.f, 0.f, 0.f};
#pragma unroll
            for (int kp = 0; kp < 9; ++kp) { u32x4 pb; pb.x = cvt_pk_bf16(s[2 * kp][0], s[2 * kp][1]); pb.y = cvt_pk_bf16(s[2 * kp][2], s[2 * kp][3]);
                if (kp < 8) { pb.z = cvt_pk_bf16(s[(2 * kp + 1) % 17][0], s[(2 * kp + 1) % 17][1]); pb.w = cvt_pk_bf16(s[(2 * kp + 1) % 17][2], s[(2 * kp + 1) % 17][3]); } else { pb.z = 0u; pb.w = 0u; }
                const bf16x8 P = as_bf16x8(pb);
#pragma unroll
                for (int df = 0; df < 4; ++df) { const LAS unsigned char* vp = lds + V_OFF + (16 * df + fr) * VS + ((qfi + 2 * kp) * 16 + 4 * fq) * 2;
                    const u32x2 lo2 = *(const LAS u32x2*)vp, hi2 = *(const LAS u32x2*)(vp + 32); u32x4 va; va.x = lo2.x; va.y = lo2.y; va.z = hi2.x; va.w = hi2.y;
                    o[df] = mfma16(as_bf16x8(va), P, o[df]); } }
#pragma unroll
            for (int df = 0; df < 4; ++df) { const int c = hq * 64 + 16 * df + 4 * fq; const u32x2 z = zc[df];
                u32x2 ov; ov.x = cvt_pk_bf16(o[df][0] * inv * siluf(bflo(z.x)), o[df][1] * inv * siluf(bfhi(z.x))); ov.y = cvt_pk_bf16(o[df][2] * inv * siluf(bflo(z.y)), o[df][3] * inv * siluf(bfhi(z.y)));
                *(u32x2*)(mix + tq * 1024 + 512 + c) = ov; }
        }
#undef ATT_LOADQ
    }
    __syncthreads();
}

template <int CTRL> __device__ __forceinline__ float dpp_f32(float v) { return __builtin_bit_cast(float, __builtin_amdgcn_update_dpp(0, __builtin_bit_cast(int, v), CTRL, 0xf, 0xf, false)); }
__device__ __forceinline__ void gla_phase(LAS unsigned char* lds, const Ctx& X, const bf16_t* proj, const float* Wg, const float* bg, bf16_t* OF, bf16_t* OB, float* SST, bool ph2, const float* gw, bf16_t* mix) {
    constexpr int RS = 272, TS = 144;
    constexpr int QA = 0, KA = 64 * RS, QX = 2 * 64 * RS, KXT = 3 * 64 * RS, VT = KXT + 128 * TS, ATT = VT + 256 * TS, DEC = ATT + 64 * TS, AW = DEC + 512, PART = AW + 2048;
    static_assert(PART + 2048 <= 147392, "gla lds");
    const int wid = X.wid;
    const float sc = 0.08838834764831845f;
    for (int item = X.vcu; item < 256; item += X.G) {
        const int half = item & 1, hd = (item >> 1) & 3, b = item >> 3, dir = ph2 ? 1 - half : half;
        bf16_t* obuf = dir ? OB : OF; const bf16_t* other = dir ? OF : OB;
        float* sst = SST + ((size_t)((b * 4 + hd) * 2 + dir)) * 32768 + (size_t)wid * 4096;
#define CHUNK(n_) (ph2 ? (dir ? 15 - (n_) : 16 + (n_)) : (dir ? 31 - (n_) : (n_)))
        __syncthreads();
        bf16x8 WgA;
        { const int fr_ = X.lane & 15, fq_ = X.lane >> 4; float wv[8];
#pragma unroll
          for (int j = 0; j < 8; ++j) wv[j] = Wg[(size_t)(dir * 16 + 8 * (fq_ & 1) + j) * 512 + hd * 128 + 16 * wid + fr_];
#pragma unroll
          for (int j = 0; j < 8; ++j) wv[j] = (fq_ < 2) ? wv[j] : 0.f;
          u32x4 p; p.x = cvt_pk_bf16(wv[0], wv[1]); p.y = cvt_pk_bf16(wv[2], wv[3]); p.z = cvt_pk_bf16(wv[4], wv[5]); p.w = cvt_pk_bf16(wv[6], wv[7]); WgA = as_bf16x8(p); }
        const f32x4 bgv = *(const f32x4*)(bg + dir * 512 + hd * 128 + 16 * wid + 4 * (X.lane >> 4));
        f32x4 S[8][2];
#pragma unroll
        for (int kf = 0; kf < 8; ++kf) { S[kf][0] = (f32x4){0.f, 0.f, 0.f, 0.f}; S[kf][1] = (f32x4){0.f, 0.f, 0.f, 0.f}; }
        if (ph2) {
#pragma unroll
            for (int kf = 0; kf < 8; ++kf)
#pragma unroll
                for (int vf = 0; vf < 2; ++vf) S[kf][vf] = *(const f32x4*)(sst + ((kf * 2 + vf) * 64 + X.lane) * 4); }
        u32x4 pa1 = (u32x4){0u, 0u, 0u, 0u}, raq[2], rak[2]; u32x2 pv[2][4];
#define TOKC(cc, i) ((size_t)b * SEQ + (size_t)(cc) * 64 + (size_t)(dir ? 63 - (i) : (i)))
#define GLA_LOADS(cc) do { int tl = X.tid; asm volatile("" : "+v"(tl)); const int l_ = tl & 63, rbl_ = l_ & 3, cql_ = l_ >> 2; \
            if (tl < 128) pa1 = *(const u32x4*)(proj + TOKC(cc, tl >> 1) * ODD_IN + 3072 + dir * 16 + (tl & 1) * 8); \
            _Pragma("unroll") for (int t = 0; t < 2; ++t) { const int pi = tl + 512 * t; const bf16_t* pp = proj + TOKC(cc, pi >> 4) * ODD_IN + hd * 128 + (pi & 15) * 8; raq[t] = *(const u32x4*)pp; rak[t] = *(const u32x4*)(pp + 512); } \
            _Pragma("unroll") for (int p = 0; p < 2; ++p) { const int ps = 2 * wid + p, rbg = ps >> 2, cg = ps & 3; \
                _Pragma("unroll") for (int r = 0; r < 4; ++r) pv[p][r] = *(const u32x2*)(proj + TOKC(cc, 4 * (4 * rbg + rbl_) + r) * ODD_IN + 1024 + hd * 256 + 4 * (16 * cg + cql_)); } } while (0)
#define GLA_STAGE_A() do { int tl = X.tid; asm volatile("" : "+v"(tl)); if (tl < 128) *(LAS u32x4*)(lds + AW + (tl >> 1) * 32 + (tl & 1) * 16) = pa1; } while (0)
#define GLA_STAGE_QK() do { int tl = X.tid; asm volatile("" : "+v"(tl)); _Pragma("unroll") for (int t = 0; t < 2; ++t) { const int pi = tl + 512 * t; \
            *(LAS u32x4*)(lds + QA + (pi >> 4) * RS + (pi & 15) * 16) = raq[t]; *(LAS u32x4*)(lds + KA + (pi >> 4) * RS + (pi & 15) * 16) = rak[t]; } } while (0)
        GLA_LOADS(CHUNK(0));
        GLA_STAGE_A(); GLA_STAGE_QK();
        __syncthreads();
#pragma unroll 1
        for (int n = 0; n < 16; ++n) {
            const int c = CHUNK(n); const int nn = n < 15 ? n + 1 : 15, cnx = CHUNK(nn);
            int tid = X.tid; asm volatile("" : "+v"(tid)); const int lane = tid & 63, fr = lane & 15, fq = lane >> 4, rb = fr, cs = fq;
            u32x2 pq[4], pk[4];
#pragma unroll
            for (int r = 0; r < 4; ++r) { const int ro = (4 * rb + r) * RS + (16 * wid + 4 * cs) * 2; pq[r] = *(const LAS u32x2*)(lds + QA + ro); pk[r] = *(const LAS u32x2*)(lds + KA + ro); }
            { const int rbl = lane & 3, cql = lane >> 2;
#pragma unroll
              for (int p = 0; p < 2; ++p) { const int ps = 2 * wid + p, rbg = ps >> 2, cg = ps & 3; LAS unsigned char* vp = lds + VT + (4 * (16 * cg + cql)) * TS + (4 * (4 * rbg + rbl)) * 2;
                  u32x2 w;
                  w.x = (pv[p][0].x & 0xffffu) | (pv[p][1].x << 16); w.y = (pv[p][2].x & 0xffffu) | (pv[p][3].x << 16); *(LAS u32x2*)(vp) = w;
                  w.x = (pv[p][0].x >> 16) | (pv[p][1].x & 0xffff0000u); w.y = (pv[p][2].x >> 16) | (pv[p][3].x & 0xffff0000u); *(LAS u32x2*)(vp + TS) = w;
                  w.x = (pv[p][0].y & 0xffffu) | (pv[p][1].y << 16); w.y = (pv[p][2].y & 0xffffu) | (pv[p][3].y << 16); *(LAS u32x2*)(vp + 2 * TS) = w;
                  w.x = (pv[p][0].y >> 16) | (pv[p][1].y & 0xffff0000u); w.y = (pv[p][2].y >> 16) | (pv[p][3].y & 0xffff0000u); *(LAS u32x2*)(vp + 3 * TS) = w; } }
            GLA_LOADS(cnx);
            float x[4][4];
#pragma unroll
            for (int t = 0; t < 4; ++t) { u32x4 av = *(const LAS u32x4*)(lds + AW + (4 * rb + t) * 32 + (fq & 1) * 16); if (fq >= 2) av = (u32x4){0u, 0u, 0u, 0u};
                const f32x4 xa = mfma16(WgA, as_bf16x8(av), bgv);
                x[t][0] = xa[0]; x[t][1] = xa[1]; x[t][2] = xa[2]; x[t][3] = xa[3]; }
            float tot[4], inc[4];
#pragma unroll
            for (int cc = 0; cc < 4; ++cc) { float run = 0.f;
#pragma unroll
                for (int r = 0; r < 4; ++r) { const float xv = x[r][cc]; run += (fminf(xv, 0.f) * 1.4426950408889634f - __builtin_amdgcn_logf(1.0f + __builtin_amdgcn_exp2f(-1.4426950408889634f * fabsf(xv)))) * 0.0625f; x[r][cc] = run; }
                tot[cc] = run; inc[cc] = run; }
#pragma unroll
            for (int cc = 0; cc < 4; ++cc) { inc[cc] += dpp_f32<0x111>(inc[cc]); inc[cc] += dpp_f32<0x112>(inc[cc]); inc[cc] += dpp_f32<0x114>(inc[cc]); inc[cc] += dpp_f32<0x118>(inc[cc]); }
            float blast[4], ref[4];
#pragma unroll
            for (int cc = 0; cc < 4; ++cc) { const float ex = inc[cc] - tot[cc];
#pragma unroll
                for (int r = 0; r < 4; ++r) x[r][cc] += ex;
                blast[cc] = __shfl(inc[cc], (lane & 48) | 15); ref[cc] = __shfl(x[0][cc], (lane & 48) | 8); }
            { float kx[4][4], eref[4], elr[4];
#pragma unroll
              for (int cc = 0; cc < 4; ++cc) { eref[cc] = __builtin_amdgcn_exp2f(ref[cc]); elr[cc] = __builtin_amdgcn_exp2f(blast[cc] - ref[cc]); }
#pragma unroll
              for (int r = 0; r < 4; ++r) { const float q4[4] = {bflo(pq[r].x) * sc, bfhi(pq[r].x) * sc, bflo(pq[r].y) * sc, bfhi(pq[r].y) * sc}; const float k4[4] = {bflo(pk[r].x), bfhi(pk[r].x), bflo(pk[r].y), bfhi(pk[r].y)};
                  float qa[4], ka[4], qx[4];
#pragma unroll
                  for (int cc = 0; cc < 4; ++cc) { const float e1 = __builtin_amdgcn_exp2f(x[r][cc] - ref[cc]), e2 = __builtin_amdgcn_rcpf(e1); qa[cc] = q4[cc] * e1; ka[cc] = k4[cc] * e2; qx[cc] = qa[cc] * eref[cc]; kx[r][cc] = ka[cc] * elr[cc]; }
                  const int ro = (4 * rb + r) * RS + (16 * wid + 4 * cs) * 2;
                  u32x2 w; w.x = cvt_pk_bf16(qa[0], qa[1]); w.y = cvt_pk_bf16(qa[2], qa[3]); *(LAS u32x2*)(lds + QA + ro) = w;
                  w.x = cvt_pk_bf16(ka[0], ka[1]); w.y = cvt_pk_bf16(ka[2], ka[3]); *(LAS u32x2*)(lds + KA + ro) = w;
                  w.x = cvt_pk_bf16(qx[0], qx[1]); w.y = cvt_pk_bf16(qx[2], qx[3]); *(LAS u32x2*)(lds + QX + ro) = w; }
#pragma unroll
              for (int cc = 0; cc < 4; ++cc) { u32x2 w; w.x = cvt_pk_bf16(kx[0][cc], kx[1][cc]); w.y = cvt_pk_bf16(kx[2][cc], kx[3][cc]);
                  *(LAS u32x2*)(lds + KXT + (16 * wid + 4 * cs + cc) * TS + (4 * rb) * 2) = w; }
              if (rb == 0) *(LAS f32x4*)(lds + DEC + (16 * wid + 4 * cs) * 4) = (f32x4){__builtin_amdgcn_exp2f(blast[0]), __builtin_amdgcn_exp2f(blast[1]), __builtin_amdgcn_exp2f(blast[2]), __builtin_amdgcn_exp2f(blast[3])}; }
            __syncthreads();
            u32x2 ov[4][2];
            if (ph2) {
#pragma unroll
                for (int fi = 0; fi < 4; ++fi) { const size_t tk = TOKC(c, 16 * fi + fr);
#pragma unroll
                    for (int vf = 0; vf < 2; ++vf) ov[fi][vf] = *(const u32x2*)(other + tk * 1024 + hd * 256 + 32 * wid + 4 * fq + 16 * vf); } }
            { const int fi = wid >> 1, fj0 = 2 * (wid & 1); f32x4 a0 = (f32x4){0.f, 0.f, 0.f, 0.f}, a1 = (f32x4){0.f, 0.f, 0.f, 0.f};
#pragma unroll
              for (int ks = 0; ks < 4; ++ks) { const bf16x8 qf_ = *(const LAS bf16x8*)(lds + QA + (16 * fi + fr) * RS + ks * 64 + fq * 16);
                  if (fj0 <= fi) a0 = mfma16(qf_, *(const LAS bf16x8*)(lds + KA + (16 * fj0 + fr) * RS + ks * 64 + fq * 16), a0);
                  if (fj0 + 1 <= fi) a1 = mfma16(qf_, *(const LAS bf16x8*)(lds + KA + (16 * (fj0 + 1) + fr) * RS + ks * 64 + fq * 16), a1); }
#pragma unroll
              for (int e = 0; e < 4; ++e) { const int i = 16 * fi + 4 * fq + e, j0 = 16 * fj0 + fr, j1 = j0 + 16; const bool k0 = dir ? (j0 < i) : (j0 <= i), k1 = dir ? (j1 < i) : (j1 <= i);
                  *(LAS unsigned short*)(lds + ATT + i * TS + j0 * 2) = f2bf1(k0 ? a0[e] : 0.f); *(LAS unsigned short*)(lds + ATT + i * TS + j1 * 2) = f2bf1(k1 ? a1[e] : 0.f); } }
            bf16x8 vb[2][2];
#pragma unroll
            for (int vf = 0; vf < 2; ++vf)
#pragma unroll
                for (int ks = 0; ks < 2; ++ks) vb[vf][ks] = *(const LAS bf16x8*)(lds + VT + (32 * wid + 16 * vf + fr) * TS + ks * 64 + fq * 16);
            f32x4 o[4][2];
#pragma unroll
            for (int fi = 0; fi < 4; ++fi) { o[fi][0] = (f32x4){0.f, 0.f, 0.f, 0.f}; o[fi][1] = (f32x4){0.f, 0.f, 0.f, 0.f}; }
#pragma unroll
            for (int a4 = 0; a4 < 4; ++a4) { bf16x8 sb[2];
#pragma unroll
                for (int vf = 0; vf < 2; ++vf) { u32x4 p; p.x = cvt_pk_bf16(S[2 * a4][vf][0], S[2 * a4][vf][1]); p.y = cvt_pk_bf16(S[2 * a4][vf][2], S[2 * a4][vf][3]); p.z = cvt_pk_bf16(S[2 * a4 + 1][vf][0], S[2 * a4 + 1][vf][1]); p.w = cvt_pk_bf16(S[2 * a4 + 1][vf][2], S[2 * a4 + 1][vf][3]); sb[vf] = as_bf16x8(p); }
#pragma unroll
                for (int fi = 0; fi < 4; ++fi) { const LAS unsigned char* qp = lds + QX + (16 * fi + fr) * RS + (32 * a4 + 4 * fq) * 2; const u32x2 lo = *(const LAS u32x2*)qp, hi = *(const LAS u32x2*)(qp + 32);
                    u32x4 qa; qa.x = lo.x; qa.y = lo.y; qa.z = hi.x; qa.w = hi.y; const bf16x8 Bq = as_bf16x8(qa); o[fi][0] = mfma16(sb[0], Bq, o[fi][0]); o[fi][1] = mfma16(sb[1], Bq, o[fi][1]); } }
#pragma unroll
            for (int kf = 0; kf < 8; ++kf) { const f32x4 d4 = *(const LAS f32x4*)((const LAS float*)(lds + DEC) + 16 * kf + 4 * fq); S[kf][0] *= d4; S[kf][1] *= d4; }
#pragma unroll
            for (int ks = 0; ks < 2; ++ks)
#pragma unroll
                for (int kf = 0; kf < 8; ++kf) { const bf16x8 a = *(const LAS bf16x8*)(lds + KXT + (16 * kf + fr) * TS + ks * 64 + fq * 16); S[kf][0] = mfma16(a, vb[0][ks], S[kf][0]); S[kf][1] = mfma16(a, vb[1][ks], S[kf][1]); }
            GLA_STAGE_A();
            __syncthreads();
#pragma unroll
            for (int ks = 0; ks < 2; ++ks)
#pragma unroll
                for (int fi = 0; fi < 4; ++fi) { const bf16x8 a = *(const LAS bf16x8*)(lds + ATT + (16 * fi + fr) * TS + ks * 64 + fq * 16); o[fi][0] = mfma16(vb[0][ks], a, o[fi][0]); o[fi][1] = mfma16(vb[1][ks], a, o[fi][1]); }
            u32x2 zv[4][2];
            if (!ph2) {
#pragma unroll
                for (int fi = 0; fi < 4; ++fi) { bf16_t* op = obuf + TOKC(c, 16 * fi + fr) * 1024 + hd * 256 + 32 * wid + 4 * fq;
#pragma unroll
                    for (int vf = 0; vf < 2; ++vf) { u32x2 w; w.x = cvt_pk_bf16(o[fi][vf][0], o[fi][vf][1]); w.y = cvt_pk_bf16(o[fi][vf][2], o[fi][vf][3]); *(u32x2*)(op + 16 * vf) = w; } }
            } else {
#pragma unroll
                for (int fi = 0; fi < 4; ++fi) { const size_t tk = TOKC(c, 16 * fi + fr);
#pragma unroll
                    for (int vf = 0; vf < 2; ++vf) zv[fi][vf] = *(const u32x2*)(proj + tk * ODD_IN + 2048 + hd * 256 + 32 * wid + 4 * fq + 16 * vf); }
#pragma unroll
                for (int fi = 0; fi < 4; ++fi) { float ss = 0.f;
#pragma unroll
                    for (int vf = 0; vf < 2; ++vf) { o[fi][vf][0] += bflo(ov[fi][vf].x); o[fi][vf][1] += bfhi(ov[fi][vf].x); o[fi][vf][2] += bflo(ov[fi][vf].y); o[fi][vf][3] += bfhi(ov[fi][vf].y);
                        ss += (o[fi][vf][0] * o[fi][vf][0] + o[fi][vf][1] * o[fi][vf][1]) + (o[fi][vf][2] * o[fi][vf][2] + o[fi][vf][3] * o[fi][vf][3]); }
                    ss += __shfl_xor(ss, 16); ss += __shfl_xor(ss, 32);
                    if (fq == 0) ((LAS float*)(lds + PART))[wid * 64 + 16 * fi + fr] = ss; }
            }
            GLA_STAGE_QK();
            __syncthreads();
            if (ph2) {
                const f32x4 gw0 = *(const f32x4*)(gw + 32 * wid + 4 * fq), gw1 = *(const f32x4*)(gw + 32 * wid + 16 + 4 * fq);
#pragma unroll
                for (int fi = 0; fi < 4; ++fi) { float tot = 0.f;
#pragma unroll
                    for (int w = 0; w < 8; ++w) tot += ((const LAS float*)(lds + PART))[w * 64 + 16 * fi + fr];
                    const float r = __builtin_amdgcn_rsqf(tot * (1.f / 256.f) + 1e-6f);
                    bf16_t* mp = mix + TOKC(c, 16 * fi + fr) * 1024 + hd * 256 + 32 * wid + 4 * fq;
#pragma unroll
                    for (int vf = 0; vf < 2; ++vf) { const f32x4 gv = vf ? gw1 : gw0; const u32x2 z = zv[fi][vf];
                        u32x2 w; w.x = cvt_pk_bf16(o[fi][vf][0] * r * gv[0] * siluf(bflo(z.x)), o[fi][vf][1] * r * gv[1] * siluf(bfhi(z.x))); w.y = cvt_pk_bf16(o[fi][vf][2] * r * gv[2] * siluf(bflo(z.y)), o[fi][vf][3] * r * gv[3] * siluf(bfhi(z.y)));
                        *(u32x2*)(mp + 16 * vf) = w; } }
                        }
        }
        if (!ph2) {
#pragma unroll
            for (int kf = 0; kf < 8; ++kf)
#pragma unroll
                for (int vf = 0; vf < 2; ++vf) *(f32x4*)(sst + ((kf * 2 + vf) * 64 + X.lane) * 4) = S[kf][vf]; }
#undef CHUNK
#undef GLA_STAGE_A
#undef GLA_STAGE_QK
#undef GLA_LOADS
#undef TOKC
    }
}
__device__ __forceinline__ void gla_finish_phase(const Ctx& X, const bf16_t* OF, const bf16_t* OB, const bf16_t* proj, const float* gw, bf16_t* mix) {
    const int gwv = X.vcu * 8 + X.wid, NGW = X.G * 8, col0 = X.lane * 16;
    f32x4 w4[4];
#pragma unroll
    for (int q = 0; q < 4; ++q) w4[q] = *(const f32x4*)(gw + (col0 & 255) + 4 * q);
#pragma unroll 2
    for (int m = gwv; m < MTOK; m += NGW) {
        const u32x4* pf = (const u32x4*)(OF + (size_t)m * 1024 + col0); const u32x4* pb = (const u32x4*)(OB + (size_t)m * 1024 + col0); const u32x4* pz = (const u32x4*)(proj + (size_t)m * ODD_IN + 2048 + col0);
        float v[16], z[16]; float ss = 0.f;
#pragma unroll
        for (int h = 0; h < 2; ++h) { const u32x4 a = pf[h], c = pb[h], zz = pz[h];
            v[8 * h + 0] = bflo(a.x) + bflo(c.x); v[8 * h + 1] = bfhi(a.x) + bfhi(c.x); v[8 * h + 2] = bflo(a.y) + bflo(c.y); v[8 * h + 3] = bfhi(a.y) + bfhi(c.y);
            v[8 * h + 4] = bflo(a.z) + bflo(c.z); v[8 * h + 5] = bfhi(a.z) + bfhi(c.z); v[8 * h + 6] = bflo(a.w) + bflo(c.w); v[8 * h + 7] = bfhi(a.w) + bfhi(c.w);
            z[8 * h + 0] = bflo(zz.x); z[8 * h + 1] = bfhi(zz.x); z[8 * h + 2] = bflo(zz.y); z[8 * h + 3] = bfhi(zz.y); z[8 * h + 4] = bflo(zz.z); z[8 * h + 5] = bfhi(zz.z); z[8 * h + 6] = bflo(zz.w); z[8 * h + 7] = bfhi(zz.w); }
#pragma unroll
        for (int e = 0; e < 16; ++e) ss += v[e] * v[e];
        ss += __shfl_xor(ss, 1); ss += __shfl_xor(ss, 2); ss += __shfl_xor(ss, 4); ss += __shfl_xor(ss, 8);
        const float r = 1.0f / sqrtf(ss * (1.f / 256.f) + 1e-6f);
        float y[16];
#pragma unroll
        for (int e = 0; e < 16; ++e) y[e] = v[e] * r * w4[e >> 2][e & 3] * siluf(z[e]);
        u32x4 o0, o1; o0.x = cvt_pk_bf16(y[0], y[1]); o0.y = cvt_pk_bf16(y[2], y[3]); o0.z = cvt_pk_bf16(y[4], y[5]); o0.w = cvt_pk_bf16(y[6], y[7]);
        o1.x = cvt_pk_bf16(y[8], y[9]); o1.y = cvt_pk_bf16(y[10], y[11]); o1.z = cvt_pk_bf16(y[12], y[13]); o1.w = cvt_pk_bf16(y[14], y[15]);
        u32x4* po = (u32x4*)(mix + (size_t)m * 1024 + col0); po[0] = o0; po[1] = o1;
    }
}

struct Args { const float* in[17]; float* out; unsigned char* ws; int ph_lo, ph_hi; };
constexpr int N_PHASES = 2 + 6 * DEPTH;
__global__ void __launch_bounds__(512, 2) fwd_mega(Args args) {
    extern __shared__ __attribute__((aligned(16))) unsigned char lds_raw[];
    LAS unsigned char* lds = (LAS unsigned char*)lds_raw;
    cg::grid_group grid = cg::this_grid();
    Ctx X; X.tid = threadIdx.x; X.lane = X.tid & 63; X.wid = __builtin_amdgcn_readfirstlane(X.tid >> 6); X.G = gridDim.x;
    { const int bx = blockIdx.x; X.vcu = (X.G % 8 == 0) ? (bx % 8) * (X.G / 8) + bx / 8 : bx; }
    const float* x_in = args.in[0]; const float* c_in = args.in[1]; const float* norm_w = args.in[2]; const float* w_ada = args.in[3]; const float* b_ada = args.in[4];
    const float* pool_scale = args.in[7]; const float* q_norm_w = args.in[8]; const float* k_norm_w = args.in[9]; const float* attn_sink = args.in[10];
    const float* w_gate_up = args.in[13]; const float* b_gate = args.in[14]; const float* gla_norm_w = args.in[15];
    unsigned char* ws = args.ws; float* out = args.out;
    float* mod = (float*)(ws + WS_MOD); bf16_t* H = (bf16_t*)(ws + WS_H); bf16_t* PROJ = (bf16_t*)(ws + WS_PROJ); bf16_t* VTg = (bf16_t*)(ws + WS_VT); bf16_t* OF = (bf16_t*)(ws + WS_OF); bf16_t* OB = (bf16_t*)(ws + WS_OB);
    bf16_t* HP = (bf16_t*)(ws + WS_HP); float* ROWSS = (float*)(ws + WS_ROWSS); float* SHW = (float*)(ws + WS_SHW);
    const int lo = args.ph_lo, hi = args.ph_hi;
    if (threadIdx.x < 16) ((LAS unsigned*)(lds + LDS_MISC))[threadIdx.x] = 0u;
    __syncthreads();
    XcdBarrier bar = xcd_barrier_post((unsigned*)(ws + WS_BAR), (volatile LAS unsigned*)(lds + LDS_MISC));
    const bool one = (hi - lo) > 1;
#define IN(k) (lo <= (k) && (k) < hi)
#define FRESH(Y) Ctx Y = X; asm volatile("" : "+v"(Y.tid), "+v"(Y.lane))
#define SEAM(k) do { if (one && IN((k) + 1)) xcd_barrier(bar); } while (0)
    if (hi < 0) grid.sync();
    if (IN(0)) { FRESH(Y); mod_phase(lds, Y, c_in, w_ada, b_ada, mod); SEAM(0); }
    if (IN(1)) { WPtrs P{args.in[5], args.in[11], args.in[12], args.in[16], args.in[6]}; FRESH(Y); shiftw_phase(lds, Y, mod, args.in[5], args.in[12], SHW); transpose_phase(lds, Y, P, ws); __syncthreads();
        prenorm_phase(Y, x_in, norm_w, mod, HP, ROWSS); SEAM(1); }
#pragma unroll 1
    for (int l = 0; l < DEPTH; ++l) {
        const int pb = 2 + 6 * l, i2 = l >> 1; const bool odd = (l & 1) != 0;
        const float* xsrc = (l == 0) ? x_in : out; const float* modl = mod + (size_t)l * 32 * 3072;
        if (IN(pb + 1)) {
            const bf16_t* Ap = HP; const bf16_t* Bp = (const bf16_t*)(ws + (odd ? WS_WINC : WS_WINA)) + (size_t)i2 * (odd ? ODD_INP : EVEN_IN) * 1024; asm volatile("" : "+s"(Ap), "+s"(Bp));
            if (!odd) { pg8::Gemm g{Ap, Bp, MTOK, EVEN_IN, D}; pg8::StaticOrder S; S.init(MTOK, EVEN_IN, X.G, (int)blockIdx.x);
                pg8::EpiProj E{PROJ, EVEN_IN, EVEN_IN, VTg, ROWSS + (size_t)l * MTOK, SHW + (size_t)l * 32 * 3328}; pg8::gemm_phase<pg8::EpiProj, pg8::StaticOrder, GEMM_ALIGN, GEMM_SP2>(lds, g, S, E); }
            else { pg8::Gemm g{Ap, Bp, MTOK, ODD_INP, D}; pg8::StaticOrder S; S.init(MTOK, ODD_INP, X.G, (int)blockIdx.x);
                pg8::EpiProj E{PROJ, ODD_IN, ODD_IN, nullptr, ROWSS + (size_t)l * MTOK, SHW + (size_t)l * 32 * 3328}; pg8::gemm_phase<pg8::EpiProj, pg8::StaticOrder, GEMM_ALIGN, GEMM_SP2>(lds, g, S, E); }
            SEAM(pb + 1);
        }
        if (IN(pb + 2)) {
#ifdef DUP_MIX
            for (int rep = 0; rep < 2; ++rep) {
#endif
            FRESH(Y); if (!odd) { pool_phase(lds, Y, PROJ, (const bf16_t*)(ws + WS_WPT) + (size_t)i2 * 4 * 16384, pool_scale + i2 * 512, H);
                attn_phase(lds, Y, PROJ, VTg, q_norm_w + i2 * 64, k_norm_w + i2 * 64, attn_sink + i2 * 8, H); }
            else gla_phase(lds, Y, PROJ, w_gate_up + (size_t)i2 * 2 * 16 * 512, b_gate + i2 * 2 * 512, OF, OB, (float*)(ws + WS_SST), false, gla_norm_w + i2 * 256, H);
#ifdef DUP_MIX
            }
#endif
            SEAM(pb + 2);
        }
        if (IN(pb + 3)) { FRESH(Y); if (odd) gla_phase(lds, Y, PROJ, w_gate_up + (size_t)i2 * 2 * 16 * 512, b_gate + i2 * 2 * 512, OF, OB, (float*)(ws + WS_SST), true, gla_norm_w + i2 * 256, H); if (odd) SEAM(pb + 3); }
        if (IN(pb + 4)) {
            const bf16_t* Ap = H; const bf16_t* Bp = (const bf16_t*)(ws + (odd ? WS_WOUTC : WS_WOUTA)) + (size_t)i2 * 1024 * 1024; asm volatile("" : "+s"(Ap), "+s"(Bp));
            pg8::Gemm g{Ap, Bp, MTOK, D, D}; pg8::StaticOrder S; S.init(MTOK, D, X.G, (int)blockIdx.x);
            pg8::EpiOut E{xsrc, out, modl + 2048, (l + 1 < DEPTH) ? HP : nullptr, norm_w + (l + 1 < DEPTH ? l + 1 : l) * 1024, mod + (size_t)(l + 1 < DEPTH ? l + 1 : l) * 32 * 3072 + 1024, ROWSS + (size_t)(l + 1 < DEPTH ? l + 1 : l) * MTOK}; pg8::gemm_phase<pg8::EpiOut, pg8::StaticOrder, GEMM_ALIGN, GEMM_SP2>(lds, g, S, E);
            if (l + 1 < DEPTH) { if (one && IN(pb + 6)) xcd_barrier(bar); }
        }
    }
#undef IN
#undef SEAM
}

#ifndef MK_ONE_LAUNCH
#define MK_ONE_LAUNCH 1
#endif
extern "C" void kernel_launch(void* const* d_in, const int* in_sizes, int n_in, void* d_out, int out_size, void* d_ws, size_t ws_size, hipStream_t stream) {
    static int grid = 0;
    if (grid == 0) {
        int dev = 0, cus = 0, per_cu = 0;
        if (hipGetDevice(&dev) != hipSuccess || hipDeviceGetAttribute(&cus, hipDeviceAttributeMultiprocessorCount, dev) != hipSuccess) { fprintf(stderr, "kernel_launch: device query failed\n"); grid = -1; return; }
        if (hipFuncSetAttribute((const void*)fwd_mega, hipFuncAttributeMaxDynamicSharedMemorySize, LDS_BYTES) != hipSuccess) { fprintf(stderr, "kernel_launch: hipFuncSetAttribute failed\n"); grid = -1; return; }
        if (hipOccupancyMaxActiveBlocksPerMultiprocessor(&per_cu, (const void*)fwd_mega, 512, LDS_BYTES) != hipSuccess || per_cu < 1) fprintf(stderr, "kernel_launch: occupancy query reports %d\n", per_cu);
        (void)hipGetLastError();
        if (n_in != 17 || out_size != MTOK * D || ws_size < WS_END) { fprintf(stderr, "kernel_launch: unexpected shapes (n_in %d out %d ws %zu)\n", n_in, out_size, ws_size); grid = -1; return; }
        grid = cus;
    }
    if (grid < 0) return;
    if (hipMemsetAsync((unsigned char*)d_ws + WS_BAR, 0, 16384, stream) != hipSuccess) fprintf(stderr, "kernel_launch: memset failed\n");
    if (hipMemsetAsync((unsigned char*)d_ws + WS_ROWSS, 0, 4 * MTOK * sizeof(float), stream) != hipSuccess) fprintf(stderr, "kernel_launch: memset failed\n");
    Args a{};
    for (int i = 0; i < 17; ++i) a.in[i] = (const float*)d_in[i];
    a.out = (float*)d_out; a.ws = (unsigned char*)d_ws;
#if MK_ONE_LAUNCH
    a.ph_lo = 0; a.ph_hi = N_PHASES;
    void* kargs[] = {&a};
    hipError_t e = hipLaunchCooperativeKernel((void*)fwd_mega, dim3(grid), dim3(512), kargs, LDS_BYTES, stream);
    if (e != hipSuccess) fprintf(stderr, "kernel_launch: cooperative launch failed: %s (grid %d)\n", hipGetErrorString(e), grid);
#else
    for (int p = 0; p < N_PHASES; ++p) { const int q = (p - 2) % 6; if (p >= 2 && (q == 5 || q == 0 || (q == 3 && (((p - 2) / 6) & 1) == 0))) continue;
        a.ph_lo = p; a.ph_hi = p + 1; void* kargs[] = {&a};
        hipError_t e = hipLaunchCooperativeKernel((void*)fwd_mega, dim3(grid), dim3(512), kargs, LDS_BYTES, stream);
        if (e != hipSuccess) { fprintf(stderr, "kernel_launch: launch of phase %d failed: %s\n", p, hipGetErrorString(e)); break; } }
#endif
}
```
